# Optimizing an MI355X kernel written in HIP

```python
import jax, jax.numpy as jnp
from jax import lax
import numpy as np

D_MODEL = 2048
BATCH = 1
SEQ = 16384
DEPTH = 2

CONV_WIDTH = D_MODEL // 2
CONV_K = 3
HEAD_DIM = 128
ATTN_WIDTH = D_MODEL // 2
N_HEADS = ATTN_WIDTH // HEAD_DIM
D_FF = 4 * D_MODEL
BLOCK_Q = 128
EPS = 1e-6

SPLIT_SIZES = (CONV_WIDTH, CONV_WIDTH, CONV_WIDTH,
               ATTN_WIDTH, ATTN_WIDTH, ATTN_WIDTH,
               N_HEADS, D_MODEL, D_MODEL)
IN_COLS = sum(SPLIT_SIZES)
SPLIT_POINTS = tuple(int(v) for v in np.cumsum(SPLIT_SIZES)[:-1])

kernel_name = "hybrid_conv_fox_gated_block"


def rmsnorm(x, g):
    xf = x.astype(jnp.float32)
    y = xf * lax.rsqrt(jnp.mean(xf * xf, axis=-1, keepdims=True) + EPS)
    return (y * g.astype(jnp.float32)).astype(x.dtype)


def causal_dwconv(u, w):
    s = u.shape[1]
    up = jnp.pad(u, ((0, 0), (CONV_K - 1, 0), (0, 0)))
    y = w[0] * up[:, 0:s, :]
    for j in range(1, CONV_K):
        y = y + w[j] * up[:, j:j + s, :]
    return y


def forgetting_attention(q, k, v, log_f):
    b, s, h, d = q.shape
    nb = s // BLOCK_Q
    c = jnp.cumsum(log_f, axis=1).transpose(0, 2, 1)
    qh = q.transpose(0, 2, 1, 3)
    kh = k.transpose(0, 2, 1, 3)
    vh = v.transpose(0, 2, 1, 3)
    scale = float(d) ** -0.5
    q_blocks = qh.reshape(b, h, nb, BLOCK_Q, d).transpose(2, 0, 1, 3, 4)
    c_blocks = c.reshape(b, h, nb, BLOCK_Q).transpose(2, 0, 1, 3)
    k_pos = jnp.arange(s)

    def one_block(args):
        qb, cb, i = args
        logits = jnp.einsum('bhqd,bhkd->bhqk', qb, kh).astype(jnp.float32) * scale
        logits = logits + cb[..., :, None] - c[..., None, :]
        q_pos = i * BLOCK_Q + jnp.arange(BLOCK_Q)
        causal = k_pos[None, :] <= q_pos[:, None]
        logits = jnp.where(causal, logits, -jnp.inf)
        p = jax.nn.softmax(logits, axis=-1)
        return jnp.einsum('bhqk,bhkd->bhqd', p.astype(vh.dtype), vh)

    out = lax.map(one_block, (q_blocks, c_blocks, jnp.arange(nb)))
    return out.transpose(1, 0, 3, 2, 4).reshape(b, s, h * d)


def setup_inputs(seed: int = 0) -> dict:
    key = jax.random.key(seed)
    ks = jax.random.split(key, 14)
    nrm = jax.random.normal
    x = nrm(ks[0], (BATCH, SEQ, D_MODEL), jnp.float32)
    g_mix = 1.0 + 0.02 * nrm(ks[1], (DEPTH, D_MODEL), jnp.float32)
    w_in = nrm(ks[2], (DEPTH, D_MODEL, IN_COLS), jnp.float32) * D_MODEL ** -0.5
    b_f = 2.0 + 0.5 * nrm(ks[3], (DEPTH, N_HEADS), jnp.float32)
    b_gate = 0.02 * nrm(ks[4], (DEPTH, 2 * D_MODEL), jnp.float32)
    conv_w = nrm(ks[5], (DEPTH, CONV_K, CONV_WIDTH), jnp.float32) * CONV_K ** -0.5
    w_conv_out = nrm(ks[6], (DEPTH, CONV_WIDTH, D_MODEL), jnp.float32) * CONV_WIDTH ** -0.5
    w_attn_out = nrm(ks[7], (DEPTH, ATTN_WIDTH, D_MODEL), jnp.float32) * ATTN_WIDTH ** -0.5
    w_mix_out = nrm(ks[8], (DEPTH, D_MODEL, D_MODEL), jnp.float32) * D_MODEL ** -0.5
    g_mlp = 1.0 + 0.02 * nrm(ks[9], (DEPTH, D_MODEL), jnp.float32)
    w_ff1 = nrm(ks[10], (DEPTH, D_MODEL, D_FF), jnp.float32) * D_MODEL ** -0.5
    w_ff2 = nrm(ks[11], (DEPTH, D_FF, D_MODEL), jnp.float32) * D_FF ** -0.5
    g_final = 1.0 + 0.02 * nrm(ks[12], (D_MODEL,), jnp.float32)
    return {"x": x, "g_mix": g_mix, "w_in": w_in, "b_f": b_f, "b_gate": b_gate,
            "conv_w": conv_w, "w_conv_out": w_conv_out, "w_attn_out": w_attn_out,
            "w_mix_out": w_mix_out, "g_mlp": g_mlp, "w_ff1": w_ff1, "w_ff2": w_ff2,
            "g_final": g_final}


def reference(x, g_mix, w_in, b_f, b_gate, conv_w, w_conv_out, w_attn_out,
              w_mix_out, g_mlp, w_ff1, w_ff2, g_final):
    b, s, _ = x.shape
    for l in range(DEPTH):
        h = rmsnorm(x, g_mix[l])
        z = jnp.einsum('bsd,dc->bsc', h, w_in[l])
        cb, cc, cv, q, k, v, f_logit, gate_c, gate_a = jnp.split(z, SPLIT_POINTS, axis=-1)

        conv_y = cb * causal_dwconv(cc * cv, conv_w[l])
        conv_branch = jnp.einsum('bsc,cd->bsd', conv_y, w_conv_out[l])

        log_f = jax.nn.log_sigmoid(f_logit.astype(jnp.float32) + b_f[l].astype(jnp.float32))
        attn = forgetting_attention(q.reshape(b, s, N_HEADS, HEAD_DIM),
                                    k.reshape(b, s, N_HEADS, HEAD_DIM),
                                    v.reshape(b, s, N_HEADS, HEAD_DIM), log_f)
        attn_branch = jnp.einsum('bsc,cd->bsd', attn, w_attn_out[l])

        gc = jax.nn.sigmoid(gate_c + b_gate[l, :D_MODEL])
        ga = jax.nn.sigmoid(gate_a + b_gate[l, D_MODEL:])
        merged = gc * conv_branch + ga * attn_branch
        x = x + jnp.einsum('bsd,de->bse', merged, w_mix_out[l])

        h = rmsnorm(x, g_mlp[l])
        u = jnp.square(jax.nn.relu(jnp.einsum('bsd,df->bsf', h, w_ff1[l])))
        x = x + jnp.einsum('bsf,fd->bsd', u, w_ff2[l])
    return rmsnorm(x, g_final)
```

```cpp
#include <hip/hip_runtime.h>
#include <hip/hip_cooperative_groups.h>
#include <hip/hip_bf16.h>
#include <cstdio>
#include <cstdint>
#include <cmath>
namespace cg = cooperative_groups;

namespace pg8 {
#define PG8_LAS __attribute__((address_space(3)))
typedef unsigned short bf16_t;
typedef short bf16x8 __attribute__((ext_vector_type(8)));
typedef float f32x4 __attribute__((ext_vector_type(4)));
typedef unsigned u32x4 __attribute__((ext_vector_type(4)));
constexpr int BM = 256, BK = 64, HALF = 128, HTB = HALF * BK * 2  , STAGE_BYTES = 8 * HTB, NXCD = 8, WGM = 2;

__host__ __device__ __forceinline__ int lds_byte(int r, int c) { const int st = (r >> 4) * 2 + (c >> 5), rr = r & 15, cc = c & 31, ob = rr * 64 + cc * 2; return st * 1024 + (ob ^ (((ob >> 9) & 1) << 5)); }
__host__ __device__ __forceinline__ void stage_rc(int b, int& R, int& C) { const int st = b / 1024, sb = b % 1024, swz = sb ^ (((sb >> 9) & 1) << 5); R = (st >> 1) * 16 + swz / 64; C = (st & 1) * 32 + (swz % 64) / 2; }
__host__ __device__ __forceinline__ int perm32(int rho) { const int n = rho >> 4, i = rho & 15; return 8 * (i >> 2) + 4 * n + (i & 3); }

struct Unit { int pm, pn; };
struct Gemm { const bf16_t* A; const bf16_t* Bt; int M, N, K, lda; };

struct StaticOrder {
    int nM, nN, nwg, G, c;
    __host__ __device__ void init(int M, int N, int G_, int c_) { nM = M / BM; nN = N / BM; nwg = nM * nN; G = G_; c = c_; }
    __host__ __device__ bool next(int i, Unit& u) const {
        const long L = (long)i * G + c; if (L >= nwg) return false;
        int wgid = (int)L; { const int q = nwg / NXCD, r = nwg % NXCD, xcd = wgid % NXCD, off = wgid / NXCD; wgid = (xcd < r ? xcd * (q + 1) : r * (q + 1) + (xcd - r) * q) + off; }
        const int nig = WGM * nN, gid = wgid / nig, fm = gid * WGM, gsz = (nM - fm) < WGM ? (nM - fm) : WGM;
        u.pm = fm + ((wgid % nig) % gsz); u.pn = (wgid % nig) / gsz; return true;
    }
    __device__ __forceinline__ void a_ready(const Unit&) const {}
    __device__ __forceinline__ void done(const Unit&) const {}
};


__device__ __forceinline__ unsigned cvt_pk_bf16(float lo, float hi) { unsigned r; asm volatile("v_cvt_pk_bf16_f32 %0, %1, %2" : "=v"(r) : "v"(lo), "v"(hi)); return r; }
__device__ __forceinline__ void unpack8(const u32x4 w, f32x4& a, f32x4& b) {
    a[0] = __uint_as_float(w.x << 16); a[1] = __uint_as_float(w.x & 0xffff0000u); a[2] = __uint_as_float(w.y << 16); a[3] = __uint_as_float(w.y & 0xffff0000u);
    b[0] = __uint_as_float(w.z << 16); b[1] = __uint_as_float(w.z & 0xffff0000u); b[2] = __uint_as_float(w.w << 16); b[3] = __uint_as_float(w.w & 0xffff0000u);
}
__device__ __forceinline__ float sum_fq(float v) {
    v += __int_as_float(__builtin_amdgcn_ds_swizzle(__float_as_int(v), 0x1f | (16 << 10)));
    const auto rr = __builtin_amdgcn_permlane32_swap(__float_as_uint(v), __float_as_uint(v), false, false);
    return __uint_as_float(rr[0]) + __uint_as_float(rr[1]);
}
__device__ __forceinline__ f32x4 sigmoid4(f32x4 v) { f32x4 o;
#pragma unroll
    for (int i = 0; i < 4; ++i) o[i] = __builtin_amdgcn_rcpf(1.0f + __expf(-v[i]));
    return o; }
enum { EP_INPROJ = 0, EP_T1 = 1, EP_MERGE = 2, EP_RESID = 3, EP_RELU2 = 4, EP_RESID_N = 5 };
template <int MODE> struct Epi {
    static constexpr bool PERM = true, AFTER_DRAIN = false;
    bf16_t* O; int ldc; const bf16_t* Gt; int ldg; const bf16_t* T; int ldt; const float* X; float* XO; const float* bias; int gate_tile0; float* RS;
    __device__ __forceinline__ void operator()(const f32x4 (&acc)[2][2][4][2], const Unit& u, int wr, int wc, int fr, int fq) const {
        run<false>(acc, u, wr, wc, fr, fq);
    }
    template <bool GATE> __device__ __forceinline__ void run(const f32x4 (&acc)[2][2][4][2], const Unit& u, int wr, int wc, int fr, int fq) const {
        const int row0 = u.pm * BM + wr * 64 + fr, col0 = u.pn * BM + wc * 32 + 8 * fq;
        const bool gate = (MODE == EP_INPROJ) && (u.pn >= gate_tile0);
        f32x4 bv[2][2];
#pragma unroll
        for (int bj = 0; bj < 2; ++bj)
#pragma unroll
            for (int n = 0; n < 2; ++n) { bv[bj][n] = (f32x4){0.f, 0.f, 0.f, 0.f}; if (MODE == EP_INPROJ) bv[bj][n] = *(const f32x4*)(bias + (gate ? col0 - gate_tile0 * BM : 0) + bj * HALF + 4 * n); }
        if (MODE == EP_INPROJ) asm volatile("" : "+v"(bv[0][0]), "+v"(bv[0][1]), "+v"(bv[1][0]), "+v"(bv[1][1]));
        if (MODE == EP_RESID_N) {
#pragma unroll
            for (int bj = 0; bj < 2; ++bj)
#pragma unroll
                for (int n = 0; n < 2; ++n) bv[bj][n] = *(const f32x4*)(bias + col0 + bj * HALF + 4 * n);
        }
        float rsc[2][4];
#pragma unroll
        for (int ai = 0; ai < 2; ++ai)
#pragma unroll
            for (int m = 0; m < 4; ++m) rsc[ai][m] = (MODE == EP_RELU2) ? __builtin_amdgcn_rcpf(RS[row0 + ai * HALF + m * 16] * (1.0f / 2048.0f) + 1e-6f) : 1.0f;
#pragma unroll
        for (int ai = 0; ai < 2; ++ai)
#pragma unroll
            for (int m = 0; m < 4; ++m) { const size_t r = (size_t)(row0 + ai * HALF + m * 16); float ss = 0.f;
#pragma unroll
                for (int bj = 0; bj < 2; ++bj) { const int c = col0 + bj * HALF; f32x4 v0 = acc[ai][bj][m][0], v1 = acc[ai][bj][m][1];
                    if (MODE == EP_INPROJ) { if (gate) { v0 = sigmoid4(v0 + bv[bj][0]); v1 = sigmoid4(v1 + bv[bj][1]); } }
                    if (MODE == EP_T1 || MODE == EP_MERGE) { f32x4 g0, g1; unpack8(*(const u32x4*)(Gt + r * ldg + c), g0, g1); v0 = v0 * g0; v1 = v1 * g1; }
                    if (MODE == EP_MERGE) { f32x4 t0, t1; unpack8(*(const u32x4*)(T + r * ldt + c), t0, t1); v0 = v0 + t0; v1 = v1 + t1; }
                    if (MODE == EP_RELU2) {
#pragma unroll
                        for (int i = 0; i < 4; ++i) { const float a = fmaxf(v0[i], 0.f), b = fmaxf(v1[i], 0.f); v0[i] = a * a * rsc[ai][m]; v1[i] = b * b * rsc[ai][m]; } }
                    if (MODE == EP_RESID_N) { const float* xp = X + r * 2048 + c; float* op = XO + r * 2048 + c;
                        const f32x4 y0 = *(const f32x4*)xp + v0, y1 = *(const f32x4*)(xp + 4) + v1; *(f32x4*)op = y0; *(f32x4*)(op + 4) = y1;
                        ss += (y0[0] * y0[0] + y0[1] * y0[1]) + (y0[2] * y0[2] + y0[3] * y0[3]) + (y1[0] * y1[0] + y1[1] * y1[1]) + (y1[2] * y1[2] + y1[3] * y1[3]);
                        v0 = y0 * bv[bj][0]; v1 = y1 * bv[bj][1]; }
                    if (MODE == EP_RESID) { const float* xp = X + r * 2048 + c; float* op = XO + r * 2048 + c;
                        const f32x4 x0 = *(const f32x4*)xp, x1 = *(const f32x4*)(xp + 4); *(f32x4*)op = x0 + v0; *(f32x4*)(op + 4) = x1 + v1; }
                    else { u32x4 w; w.x = cvt_pk_bf16(v0[0], v0[1]); w.y = cvt_pk_bf16(v0[2], v0[3]); w.z = cvt_pk_bf16(v1[0], v1[1]); w.w = cvt_pk_bf16(v1[2], v1[3]);
                        *(u32x4*)(O + r * ldc + c) = w; } }
                if (MODE == EP_INPROJ) { if (u.pn >= ldt && u.pn < ldt + 8) {
#pragma unroll
                    for (int bj = 0; bj < 2; ++bj) { const f32x4 a = acc[ai][bj][m][0], b = acc[ai][bj][m][1];
                        float s2 = (a[0] * a[0] + a[1] * a[1]) + (a[2] * a[2] + a[3] * a[3]) + (b[0] * b[0] + b[1] * b[1]) + (b[2] * b[2] + b[3] * b[3]);
                        s2 = sum_fq(s2);
                        if (fq == 0) atomicAdd(RS + (size_t)((u.pn - ldt) * 2 + bj) * 16384 + r, s2); } } }
                if (MODE == EP_RESID_N) { ss = sum_fq(ss); if (fq == 0) atomicAdd(RS + r, ss); }
                if (MODE == EP_T1 || MODE == EP_MERGE || MODE == EP_RESID || MODE == EP_RESID_N) asm volatile("" ::: "memory"); }
    }
};

template <class Epi, class Sched, bool ALIGN_EPI = false, bool SP2 = false>
__device__ __forceinline__ void gemm_phase(PG8_LAS unsigned char* lds, const Gemm g, const Sched& S, const Epi& E) {
    int tid_ = threadIdx.x; asm volatile("" : "+v"(tid_));
    const int tid = tid_, wid = __builtin_amdgcn_readfirstlane(tid >> 6), lane = tid & 63, wr = wid >> 2, wc = wid & 3, fr = lane & 15, fq = lane >> 4;
    const int K = g.K, nt = K / BK, lda = g.lda;
    unsigned voffA[2], voffB[2];
#pragma unroll
    for (int i = 0; i < 2; ++i) { int R, C; stage_rc(tid * 16 + i * 8192, R, C); const int Rb = Epi::PERM ? ((R & ~31) + perm32(R & 31)) : R;
        voffA[i] = (unsigned)(R * lda + C) * 2u; voffB[i] = (unsigned)(Rb * K + C) * 2u; }
    const size_t kstep = (size_t)(BK * 2);
    const size_t hstepA = (size_t)HALF * lda * 2, hstepB = (size_t)HALF * K * 2;
    const size_t tstepA = 2 * hstepA, tstepB = 2 * hstepB;
    const unsigned ldsw = (unsigned)wid * 1024u;
    const int aoff = lds_byte(wr * 64 + fr, fq * 8), boff = lds_byte(wc * 32 + fr, fq * 8);
#define PG8_SA(b, h) (((b) * 2 + (h)) * HTB)
#define PG8_SB(b, h) ((4 + (b) * 2 + (h)) * HTB)
#ifdef EXP_DMA2
#define PG8_NREP 2
#else
#define PG8_NREP 1
#endif
#define PG8_STAGE(bufoff, gbase, voff) do { _Pragma("unroll") for (int _i = 0; _i < 2; ++_i) _Pragma("unroll") for (int _r = 0; _r < PG8_NREP; ++_r) \
        __builtin_amdgcn_global_load_lds((const unsigned*)((const char*)(gbase) + (voff)[_i]), (PG8_LAS unsigned*)(lds + (bufoff) + ldsw + _i * 8192), 16, 0, 0); } while (0)
#ifdef EXP_LDS2
#define PG8_DUP(addr) do { bf16x8 _d; asm volatile("ds_read_b128 %0, %1" : "=v"(_d) : "v"((unsigned)(addr)) : "memory"); } while (0)
#else
#define PG8_DUP(addr) do { } while (0)
#endif
#define PG8_LDA(dst, b, h) do { _Pragma("unroll") for (int m = 0; m < 4; ++m) _Pragma("unroll") for (int k = 0; k < 2; ++k) { dst[m][k] = *(const PG8_LAS bf16x8*)(lds + PG8_SA(b, h) + aoff + m * 2048 + k * 1024); PG8_DUP((unsigned)(uintptr_t)(lds + PG8_SA(b, h) + aoff + m * 2048 + k * 1024)); } } while (0)
#define PG8_LDB(dst, b, h) do { _Pragma("unroll") for (int n = 0; n < 2; ++n) _Pragma("unroll") for (int k = 0; k < 2; ++k) { dst[n][k] = *(const PG8_LAS bf16x8*)(lds + PG8_SB(b, h) + boff + n * 2048 + k * 1024); PG8_DUP((unsigned)(uintptr_t)(lds + PG8_SB(b, h) + boff + n * 2048 + k * 1024)); } } while (0)
#define PG8_MMA(ai, bj, At, Bt) do { __builtin_amdgcn_s_setprio(1); _Pragma("unroll") for (int m = 0; m < 4; ++m) _Pragma("unroll") for (int n = 0; n < 2; ++n) _Pragma("unroll") for (int k = 0; k < 2; ++k) \
        acc[ai][bj][m][n] = __builtin_amdgcn_mfma_f32_16x16x32_bf16(Bt[n][k], At[m][k], acc[ai][bj][m][n], 0, 0, 0); __builtin_amdgcn_s_setprio(0); } while (0)
#ifdef EXP_DMA2
#define PG8_WAIT_V(n) do { if ((n) == 0) asm volatile("s_waitcnt vmcnt(0)" ::: "memory"); else if ((n) == 2) asm volatile("s_waitcnt vmcnt(4)" ::: "memory"); else if ((n) == 4) asm volatile("s_waitcnt vmcnt(8)" ::: "memory"); \
    else if ((n) == 6) asm volatile("s_waitcnt vmcnt(12)" ::: "memory"); else asm volatile("s_waitcnt vmcnt(16)" ::: "memory"); } while (0)
#else
#define PG8_WAIT_V(n) asm volatile("s_waitcnt vmcnt(" #n ")" ::: "memory")
#endif
#define PG8_WAIT_L(n) asm volatile("s_waitcnt lgkmcnt(" #n ")" ::: "memory")
#define PG8_BAR __builtin_amdgcn_s_barrier()
#define PG8_SCHED __builtin_amdgcn_sched_barrier(0)
    Unit cur, nxt; int ui = 0;
    if (!S.next(0, cur)) return;
    f32x4 acc[2][2][4][2];
#pragma unroll
    for (int a = 0; a < 2; ++a)
#pragma unroll
        for (int b = 0; b < 2; ++b)
#pragma unroll
            for (int m = 0; m < 4; ++m)
#pragma unroll
                for (int n = 0; n < 2; ++n) acc[a][b][m][n] = (f32x4){0.f, 0.f, 0.f, 0.f};
    bf16x8 At[4][2], B0[2][2], B1[2][2];
    const char* cA = (const char*)g.A + (size_t)cur.pm * tstepA; const char* cB = (const char*)g.Bt + (size_t)cur.pn * tstepB;
    S.a_ready(cur);
    if constexpr (SP2) {
        PG8_STAGE(PG8_SB(0, 0), cB, voffB); PG8_STAGE(PG8_SB(0, 1), cB + hstepB, voffB); PG8_STAGE(PG8_SA(0, 0), cA, voffA); PG8_STAGE(PG8_SA(0, 1), cA + hstepA, voffA);
        if (wr == 1) PG8_BAR;
        PG8_WAIT_V(2); PG8_BAR;
        PG8_STAGE(PG8_SB(1, 0), cB + kstep, voffB); PG8_STAGE(PG8_SA(1, 0), cA + kstep, voffA); PG8_STAGE(PG8_SB(1, 1), cB + hstepB + kstep, voffB);
        PG8_WAIT_V(6); PG8_BAR;
    } else {
        PG8_STAGE(PG8_SB(0, 0), cB, voffB); PG8_STAGE(PG8_SA(0, 0), cA, voffA); PG8_STAGE(PG8_SB(0, 1), cB + hstepB, voffB); PG8_STAGE(PG8_SA(0, 1), cA + hstepA, voffA);
        if (wr == 1) PG8_BAR;
        PG8_WAIT_V(4); PG8_BAR;
        PG8_STAGE(PG8_SB(1, 0), cB + kstep, voffB); PG8_STAGE(PG8_SA(1, 0), cA + kstep, voffA); PG8_STAGE(PG8_SB(1, 1), cB + hstepB + kstep, voffB);
        PG8_WAIT_V(6); PG8_BAR;
    }
    for (;;) {
        const bool has_next = S.next(ui + 1, nxt);
        const char* nA = has_next ? (const char*)g.A + (size_t)nxt.pm * tstepA : cA; const char* nB = has_next ? (const char*)g.Bt + (size_t)nxt.pn * tstepB : cB;
        for (int t = 0; t < nt; t += 2) {
            const bool last = (t == nt - 2);
            const char* a1 = cA + (size_t)(t + 1) * kstep;
            const char* a2 = last ? nA : cA + (size_t)(t + 2) * kstep; const char* b2 = last ? nB : cB + (size_t)(t + 2) * kstep;
            const char* a3 = a2 + kstep; const char* b3 = b2 + kstep;
            if (last && has_next) S.a_ready(nxt);
            if constexpr (SP2) {
#ifdef TEST_DRAIN
            if (Epi::PERM && sizeof(Epi) && TEST_DRAIN) PG8_WAIT_V(0);
#endif
            PG8_LDB(B0, 0, 0); PG8_LDB(B1, 0, 1); PG8_SCHED; PG8_LDA(At, 0, 0); PG8_STAGE(PG8_SA(1, 1), a1 + hstepA, voffA);
            PG8_WAIT_V(8); PG8_WAIT_L(0); PG8_BAR; PG8_MMA(0, 0, At, B0); PG8_MMA(0, 1, At, B1); PG8_BAR; PG8_SCHED;
            PG8_LDA(At, 0, 1); PG8_STAGE(PG8_SB(0, 0), b2, voffB); PG8_STAGE(PG8_SB(0, 1), b2 + hstepB, voffB); PG8_STAGE(PG8_SA(0, 0), a2, voffA);
            PG8_WAIT_V(8); PG8_WAIT_L(0); PG8_BAR; PG8_MMA(1, 0, At, B0); PG8_MMA(1, 1, At, B1); PG8_BAR; PG8_SCHED;
            PG8_LDB(B0, 1, 0); PG8_LDB(B1, 1, 1); PG8_SCHED; PG8_LDA(At, 1, 0); PG8_STAGE(PG8_SA(0, 1), a2 + hstepA, voffA);
            PG8_WAIT_V(8); PG8_WAIT_L(0); PG8_BAR; PG8_MMA(0, 0, At, B0); PG8_MMA(0, 1, At, B1); PG8_BAR; PG8_SCHED;
            PG8_LDA(At, 1, 1); PG8_STAGE(PG8_SB(1, 0), b3, voffB); PG8_STAGE(PG8_SB(1, 1), b3 + hstepB, voffB); PG8_STAGE(PG8_SA(1, 0), a3, voffA);
            PG8_WAIT_V(8); PG8_WAIT_L(0); PG8_BAR; PG8_MMA(1, 0, At, B0); PG8_MMA(1, 1, At, B1); PG8_BAR; PG8_SCHED;
            } else {
            PG8_LDB(B0, 0, 0); PG8_SCHED; PG8_LDA(At, 0, 0); PG8_STAGE(PG8_SA(1, 1), a1 + hstepA, voffA);
            PG8_WAIT_L(8); PG8_BAR; PG8_WAIT_L(0); PG8_MMA(0, 0, At, B0); PG8_BAR; PG8_SCHED;
            PG8_LDB(B1, 0, 1); PG8_STAGE(PG8_SB(0, 0), b2, voffB);
            PG8_BAR; PG8_WAIT_L(0); PG8_MMA(0, 1, At, B1); PG8_BAR;
            PG8_LDA(At, 0, 1); PG8_STAGE(PG8_SA(0, 0), a2, voffA);
            PG8_BAR; PG8_WAIT_L(0); PG8_MMA(1, 0, At, B0); PG8_BAR; PG8_SCHED;
            PG8_STAGE(PG8_SB(0, 1), b2 + hstepB, voffB);
            PG8_WAIT_V(6); PG8_BAR; PG8_MMA(1, 1, At, B1); PG8_BAR;
            PG8_LDB(B0, 1, 0); PG8_SCHED; PG8_LDA(At, 1, 0); PG8_STAGE(PG8_SA(0, 1), a2 + hstepA, voffA);
            PG8_WAIT_L(8); PG8_BAR; PG8_WAIT_L(0); PG8_MMA(0, 0, At, B0); PG8_BAR; PG8_SCHED;
            PG8_LDB(B1, 1, 1); PG8_STAGE(PG8_SB(1, 0), b3, voffB);
            PG8_BAR; PG8_WAIT_L(0); PG8_MMA(0, 1, At, B1); PG8_BAR;
            PG8_LDA(At, 1, 1); PG8_STAGE(PG8_SA(1, 0), a3, voffA);
            PG8_BAR; PG8_WAIT_L(0); PG8_MMA(1, 0, At, B0); PG8_BAR; PG8_SCHED;
            PG8_STAGE(PG8_SB(1, 1), b3 + hstepB, voffB);
            PG8_WAIT_V(6); PG8_BAR; PG8_MMA(1, 1, At, B1); PG8_BAR;
            }
        }
        if constexpr (ALIGN_EPI) { if (wr == 0) PG8_BAR; }
        if constexpr (!Epi::AFTER_DRAIN) { E(acc, cur, wr, wc, fr, fq); S.done(cur); }
        if (!has_next) break;
#pragma unroll
        for (int a = 0; a < 2; ++a)
#pragma unroll
            for (int b = 0; b < 2; ++b)
#pragma unroll
                for (int m = 0; m < 4; ++m)
#pragma unroll
                    for (int n = 0; n < 2; ++n) acc[a][b][m][n] = (f32x4){0.f, 0.f, 0.f, 0.f};
        cur = nxt; cA = nA; cB = nB; ++ui;
        if constexpr (ALIGN_EPI) { if (wr == 1) PG8_BAR; }
    }
    PG8_WAIT_V(0);
    if constexpr (!ALIGN_EPI) { if (wr == 0) PG8_BAR; }
    PG8_BAR;
    if constexpr (Epi::AFTER_DRAIN) { E.fused(acc, cur, wr, wc, fr, fq, lds, wid, lane); S.done(cur); }
#undef PG8_SA
#undef PG8_SB
#undef PG8_STAGE
#undef PG8_LDA
#undef PG8_LDB
#undef PG8_MMA
#undef PG8_WAIT_V
#undef PG8_WAIT_L
#undef PG8_BAR
#undef PG8_SCHED
}
}
namespace att {
constexpr int B = 1, H = 8, HKV = 8, SQ = 16384, SKV = 16384, D = 128, QOFF = 0, WINDOW = SKV;
constexpr int OP = 1024;
constexpr int ZP = 10240;
constexpr float THR = 8.f;
constexpr bool WSKIP = false;
constexpr float SCALE = 0.08838834764831845f;
constexpr int NW = 8, QBLK = 32, KVBLK = 64, QB = NW * QBLK;
constexpr int SHM_V = KVBLK * D * 2, SHM_K = KVBLK * D * 2;
constexpr int LDS_BYTES = 2 * SHM_V + 2 * SHM_K + NW * 64 * 4;

using bf16 = __hip_bfloat16;
typedef short bf16x8 __attribute__((ext_vector_type(8)));
typedef short s16x4 __attribute__((ext_vector_type(4)));
typedef float f32x16 __attribute__((ext_vector_type(16)));
typedef float f32x4 __attribute__((ext_vector_type(4)));
typedef unsigned u32x4 __attribute__((ext_vector_type(4)));
template <class A, class Bt> struct same_t { static constexpr bool v = false; };
template <class A> struct same_t<A, A> { static constexpr bool v = true; };

#define KSWZ(row, colB) ((row) * 256 + ((colB) ^ (((row) & 7) << 4)))
#define SBAR() __builtin_amdgcn_sched_barrier(0)
__device__ __forceinline__ int v_st(int k, int c) { const int kk = (k & ~0xC) | ((k & 4) << 1) | ((k & 8) >> 1); return ((kk >> 3) * 4 + (c >> 5)) * 512 + ((kk & 7) * 32 + (c & 31)) * 2; }
__device__ __forceinline__ int v_rd_base(int lane) { return ((lane & 3) << 3) | (((lane >> 2) & 3) << 6) | (((lane >> 4) & 1) << 5) | (((lane >> 5) & 1) << 8); }
constexpr int v_rd_off(int d0, int ks, int half) { return d0 * 512 + ks * 4096 + half * 2048; }
__device__ __forceinline__ int crow(int r, int hi) { return (r & 3) + 8 * (r >> 2) + 4 * hi; }
__device__ __forceinline__ unsigned cvtpk(float lo, float hi) {
    unsigned r; asm volatile("v_cvt_pk_bf16_f32 %0, %1, %2" : "=v"(r) : "v"(lo), "v"(hi)); return r;
}
__device__ __forceinline__ bf16x8 pack8(f32x4 a, f32x4 b) {
    u32x4 w = {cvtpk(a[0], a[1]), cvtpk(a[2], a[3]), cvtpk(b[0], b[1]), cvtpk(b[2], b[3])};
    return *reinterpret_cast<bf16x8*>(&w);
}
template <class T> __device__ __forceinline__ bf16x8 load8(const T* p) {
    if constexpr (same_t<T, float>::v) { return pack8(*(const f32x4*)p, *(const f32x4*)(p + 4)); }
    else { return *reinterpret_cast<const bf16x8*>(p); }
}
__device__ __forceinline__ void mask_tile(f32x16& p0, f32x16& p1, int dq, unsigned W) {
    const float NEG = -__builtin_inff();
#pragma unroll
    for (int r = 0; r < 16; ++r) {
        const int c = (r & 3) + 8 * (r >> 2);
        if ((unsigned)(dq - c) >= W) p0[r] = NEG;
        if ((unsigned)(dq - c - 32) >= W) p1[r] = NEG;
    }
}
__device__ __forceinline__ void bias_tile(f32x16& p0, f32x16& p1, const float* cst, int hi) {
#pragma unroll
    for (int i = 0; i < 4; ++i) { const f32x4 a = *(const f32x4*)(cst + 8 * i + 4 * hi);
#pragma unroll
        for (int j = 0; j < 4; ++j) p0[4 * i + j] -= a[j]; }
    SBAR();
#pragma unroll
    for (int i = 0; i < 4; ++i) { const f32x4 b = *(const f32x4*)(cst + 32 + 8 * i + 4 * hi);
#pragma unroll
        for (int j = 0; j < 4; ++j) p1[4 * i + j] -= b[j]; }
}
__device__ __forceinline__ void partialSM(f32x16& p0, f32x16& p1, float& m_reg, float& mn, float& alpha) {
    float pmax = p0[0]; for (int r = 1; r < 16; ++r) pmax = fmaxf(pmax, p0[r]); for (int r = 0; r < 16; ++r) pmax = fmaxf(pmax, p1[r]);
    { auto rr = __builtin_amdgcn_permlane32_swap(__float_as_uint(pmax), __float_as_uint(pmax), false, false);
      pmax = fmaxf(__uint_as_float(rr[0]), __uint_as_float(rr[1])); }
    constexpr float C2 = 1.4426950408889634f * SCALE;
    if (__builtin_expect(__all((pmax - m_reg) * SCALE <= THR), 1)) { mn = m_reg; alpha = 1.f; }
    else { mn = fmaxf(m_reg, pmax); alpha = __builtin_amdgcn_exp2f((m_reg - mn) * C2); m_reg = mn; }
    const float mnL = -mn * C2;
    for (int r = 0; r < 16; ++r) p0[r] = fmaf(p0[r], C2, mnL); for (int r = 0; r < 16; ++r) p1[r] = fmaf(p1[r], C2, mnL);
    for (int r = 0; r < 16; ++r) p0[r] = __builtin_amdgcn_exp2f(p0[r]);
}
__device__ __forceinline__ void finishSM(f32x16& p0, f32x16& p1, float alpha, float& l_reg, bf16x8& pa0, bf16x8& pa1, bf16x8& pa2, bf16x8& pa3) {
    for (int r = 0; r < 16; ++r) p1[r] = __builtin_amdgcn_exp2f(p1[r]);
    float ps = 0; for (int r = 0; r < 16; ++r) ps += p0[r]; for (int r = 0; r < 16; ++r) ps += p1[r];
    { auto rr = __builtin_amdgcn_permlane32_swap(__float_as_uint(ps), __float_as_uint(ps), false, false);
      ps = __uint_as_float(rr[0]) + __uint_as_float(rr[1]); }
    l_reg = l_reg * alpha + ps;
#define PK4(P, B_, OUT) do { unsigned a0 = cvtpk(P[B_+0], P[B_+1]), a1 = cvtpk(P[B_+2], P[B_+3]);                          \
        unsigned b0 = cvtpk(P[B_+4], P[B_+5]), b1 = cvtpk(P[B_+6], P[B_+7]);                                             \
        auto r0 = __builtin_amdgcn_permlane32_swap(a0, b0, false, false); auto r1 = __builtin_amdgcn_permlane32_swap(a1, b1, false, false); \
        u32x4 w = {r0[0], r1[0], r0[1], r1[1]}; OUT = *reinterpret_cast<bf16x8*>(&w); } while (0)
    PK4(p0, 0, pa0); PK4(p0, 8, pa1); PK4(p1, 0, pa2); PK4(p1, 8, pa3);
#undef PK4
}
template <int KB, bool SK>
__device__ __forceinline__ void qkt(f32x16& p0, f32x16& p1, const char* K_lds, int r32, int hi, const bf16x8* qr, bool act) {
    if (SK && !act) { const float NEG = -__builtin_inff();
#pragma unroll
        for (int r = 0; r < 16; ++r) { p0[r] = NEG; p1[r] = NEG; } return; }
    p0 = f32x16{}; p1 = f32x16{};
    const char* kb[4];
#pragma unroll
    for (int dd = 0; dd < 4; ++dd) kb[dd] = K_lds + KB * SHM_K + KSWZ(r32, (dd * 16 + hi * 8) * 2);
#pragma unroll
    for (int d0 = 0; d0 < 8; ++d0) { const char* a = kb[d0 & 3] + (d0 >> 2) * 128;
        bf16x8 b0 = *reinterpret_cast<const bf16x8*>(a);
        bf16x8 b1 = *reinterpret_cast<const bf16x8*>(a + 32 * 256);
        p0 = __builtin_amdgcn_mfma_f32_32x32x16_bf16(b0, qr[d0], p0, 0, 0, 0);
        p1 = __builtin_amdgcn_mfma_f32_32x32x16_bf16(b1, qr[d0], p1, 0, 0, 0); }
}
template <int VB, bool SK>
__device__ __forceinline__ void pv_tile(f32x16* o, int vb0, bf16x8 pa0, bf16x8 pa1, bf16x8 pa2, bf16x8 pa3, bool act) {
    if (SK && !act) return;
#define TRRD(dst, off) asm volatile("ds_read_b64_tr_b16 %0, %1 offset:%2" : "=&v"(dst) : "v"(vb0), "i"(off) : "memory")
#define PV_D0(d0) do { s16x4 l0, l1, l2, l3, h0, h1, h2, h3; constexpr int b_ = VB * SHM_V + v_rd_off(d0, 0, 0);     \
        TRRD(l0, b_); TRRD(h0, b_ + 2048); TRRD(l1, b_ + 4096); TRRD(h1, b_ + 6144); TRRD(l2, b_ + 8192); TRRD(h2, b_ + 10240); TRRD(l3, b_ + 12288); TRRD(h3, b_ + 14336); \
        asm volatile("s_waitcnt lgkmcnt(0)" ::: "memory"); SBAR();                 \
        o[d0] = __builtin_amdgcn_mfma_f32_32x32x16_bf16(pa0, (bf16x8){l0[0], l0[1], l0[2], l0[3], h0[0], h0[1], h0[2], h0[3]}, o[d0], 0, 0, 0);   \
        o[d0] = __builtin_amdgcn_mfma_f32_32x32x16_bf16(pa1, (bf16x8){l1[0], l1[1], l1[2], l1[3], h1[0], h1[1], h1[2], h1[3]}, o[d0], 0, 0, 0);   \
        o[d0] = __builtin_amdgcn_mfma_f32_32x32x16_bf16(pa2, (bf16x8){l2[0], l2[1], l2[2], l2[3], h2[0], h2[1], h2[2], h2[3]}, o[d0], 0, 0, 0);   \
        o[d0] = __builtin_amdgcn_mfma_f32_32x32x16_bf16(pa3, (bf16x8){l3[0], l3[1], l3[2], l3[3], h3[0], h3[1], h3[2], h3[3]}, o[d0], 0, 0, 0); } while (0)
    PV_D0(0); PV_D0(1); PV_D0(2); PV_D0(3);
#undef PV_D0
#undef TRRD
}

template <class TIn, class TOut> struct BlockRef { const TIn* Q; const TIn* K; TOut* O; int P0; const float* C; int JLO; };
template <class TIn> struct Seam {
    bf16x8 qr[8];
    bf16x8 st_v0, st_v1, st_k0, st_k1; f32x4 sf0, sf1, sf2, sf3;
    f32x4 tq[16];
};
__device__ __forceinline__ int swa_jlo(int P0, int W) { const int lowk = P0 - W + 1; return lowk > 0 ? lowk / KVBLK : 0; }
#define ROW(p, k0, rr) ((p) + (size_t)((k0) + (rr)) * ZP + sc)
#define VMW() asm volatile("s_waitcnt vmcnt(0)" ::: "memory")
#define VMWN(n) asm volatile("s_waitcnt vmcnt(%0)" :: "i"(n) : "memory")
#define SLOAD_H(Kp, Vp, k0) do { S.st_v0 = load8<TIn>(ROW(Vp, k0, sr)); S.st_v1 = load8<TIn>(ROW(Vp, k0, 32 + sr));              \
                         S.st_k0 = load8<TIn>(ROW(Kp, k0, sr)); S.st_k1 = load8<TIn>(ROW(Kp, k0, 32 + sr)); } while (0)
#define SWRITE_HK(bf) do { *(bf16x8*)(K_lds + (bf) * SHM_K + kws) = S.st_k0; *(bf16x8*)(K_lds + (bf) * SHM_K + kws + 32 * 256) = S.st_k1; } while (0)
#define SWRITE_HV(bf) do { *(bf16x8*)(V_lds + (bf) * SHM_V + vst0) = S.st_v0; *(bf16x8*)(V_lds + (bf) * SHM_V + vst1) = S.st_v1; } while (0)
#define SWRITE_H(bf) do { SWRITE_HV(bf); SWRITE_HK(bf); } while (0)
#define SLOAD_F(p, k0) do { S.sf0 = *(const f32x4*)ROW(p, k0, sr); S.sf1 = *(const f32x4*)(ROW(p, k0, sr) + 4);                \
                            S.sf2 = *(const f32x4*)ROW(p, k0, 32 + sr); S.sf3 = *(const f32x4*)(ROW(p, k0, 32 + sr) + 4); } while (0)
#define SWRITE_KF(bf) do { *(bf16x8*)(K_lds + (bf) * SHM_K + kws) = pack8(S.sf0, S.sf1); *(bf16x8*)(K_lds + (bf) * SHM_K + kws + 32 * 256) = pack8(S.sf2, S.sf3); } while (0)
#define SWRITE_VF(bf) do { *(bf16x8*)(V_lds + (bf) * SHM_V + vst0) = pack8(S.sf0, S.sf1); *(bf16x8*)(V_lds + (bf) * SHM_V + vst1) = pack8(S.sf2, S.sf3); } while (0)
template <class TIn, class TOut>
__device__ __forceinline__ void causal_swa_prime(const BlockRef<TIn, TOut>& cur, int W, char* lds, Seam<TIn>& S) {
    constexpr bool F32 = same_t<TIn, float>::v;
    int tid_ = threadIdx.x; asm volatile("" : "+v"(tid_));
    const int tid = tid_, wid = __builtin_amdgcn_readfirstlane(tid >> 6), lane = tid & 63, r32 = lane & 31, hi = lane >> 5;
    const int sr = tid >> 4, sc = (tid & 15) * 8, kws = KSWZ(sr, sc * 2); char* K_lds = lds + 2 * SHM_V;
    const int kb0 = cur.JLO * KVBLK;
    for (int d0 = 0; d0 < 8; ++d0) S.qr[d0] = load8<TIn>(cur.Q + (size_t)(wid * QBLK + r32) * ZP + d0 * 16 + hi * 8);
    if constexpr (F32) { SLOAD_F((const float*)cur.K, kb0); VMW(); SWRITE_KF(0); SBAR(); SLOAD_F((const float*)(cur.K + 1024), kb0); }
    else { SLOAD_H(cur.K, (cur.K + 1024), kb0); VMW(); SWRITE_HK(0); }
    __syncthreads();
}
template <class TIn, class TOut>
__device__ __forceinline__ void causal_swa_block(const BlockRef<TIn, TOut>& cur, const BlockRef<TIn, TOut>& nxt, int skv, int W, char* lds, Seam<TIn>& S, const float* csl) {
    constexpr bool F32 = same_t<TIn, float>::v;
    int tid_ = threadIdx.x; asm volatile("" : "+v"(tid_));
    const int tid = tid_, wid = __builtin_amdgcn_readfirstlane(tid >> 6), lane = tid & 63, r32 = lane & 31, hi = lane >> 5;
    const int j_lo = cur.JLO;
    int j_hi = (cur.P0 + QB - 1) / KVBLK + 1; if (j_hi > skv / KVBLK) j_hi = skv / KVBLK;
    const int NT = j_hi - j_lo;
    const int kbn = nxt.JLO * KVBLK;
    const int qlo = cur.P0 + wid * QBLK, qm = qlo + r32 - 4 * hi;
    char* V_lds = lds; char* K_lds = lds + 2 * SHM_V;
    float* ws = (float*)(lds + 2 * SHM_V + 2 * SHM_K) + wid * 64; float* li_l = ws, * al_l = ws + 32;
    float m_reg = -1e30f, l_reg = 0; f32x16 o[4] = {};
    const int sr = tid >> 4, sc = (tid & 15) * 8, vst0 = v_st(sr, sc), vst1 = v_st(32 + sr, sc), kws = KSWZ(sr, sc * 2);
    const int vb0 = (int)(uintptr_t)V_lds + v_rd_base(lane);
    const TIn* Kh = cur.K; const TIn* Vh = (cur.K + 1024);
#define RESC(a) do { if (__any((a) < 1.f)) { if (hi == 0) al_l[r32] = (a); asm volatile("s_waitcnt lgkmcnt(0)" ::: "memory");              \
                     for (int d_ = 0; d_ < 4; ++d_) for (int r = 0; r < 16; ++r) o[d_][r] *= al_l[crow(r, hi)]; } } while (0)
#define KBASE(t) ((j_lo + (t)) * KVBLK)
#define ACT(t) (KBASE(t) <= qlo + QBLK - 1 && KBASE(t) + KVBLK - 1 >= qlo - W + 1)
#define MASKT(P0_, P1_, t) do { const int kb_ = KBASE(t); bias_tile(P0_, P1_, csl + kb_, hi); if ((!SK || ACT(t)) && (kb_ + KVBLK - 1 > qlo || kb_ <= qlo + QBLK - 1 - W)) mask_tile(P0_, P1_, qm - kb_, (unsigned)W); } while (0)
    constexpr int NQL = F32 ? 16 : 8;
    constexpr bool SK = WSKIP && !F32;
#define SEAM_K0() do { VMWN(NQL); if constexpr (F32) { SWRITE_KF(0); SBAR(); SLOAD_F((const float*)(nxt.K + 1024), kbn); } else { SWRITE_HK(0); } SBAR(); } while (0)
    f32x16 pA0, pA1, pB0, pB1; float mnA, mnB, alA, alB; bf16x8 pa0, pa1, pa2, pa3;
    if constexpr (F32) { VMW(); SWRITE_VF(0); SBAR(); } else { SWRITE_HV(0); SBAR(); }
    if (NT > 1) { if constexpr (F32) SLOAD_F((const float*)Kh, KBASE(1)); else SLOAD_H(Kh, Vh, KBASE(1)); }
    SBAR(); qkt<0, SK>(pA0, pA1, K_lds, r32, hi, S.qr, ACT(0));
    if constexpr (F32) { if (NT > 1) { VMW(); SWRITE_KF(1); SBAR(); SLOAD_F((const float*)Vh, KBASE(1)); } }
    MASKT(pA0, pA1, 0); partialSM(pA0, pA1, m_reg, mnA, alA);
    if (NT > 1) { VMW(); if constexpr (F32) { SWRITE_VF(1); SBAR(); if (NT > 2) SLOAD_F((const float*)Kh, KBASE(2)); } else SWRITE_H(1); }
    __syncthreads();
#define HALF_STEP(PX0, PX1, mnX, alX, PY0, PY1, alY, t, KB, VB, SB) do {                                                      \
        if constexpr (!F32) { if ((t) + 1 < NT) SLOAD_H(Kh, Vh, KBASE((t) + 1)); }     \
        SBAR(); qkt<KB, SK>(PX0, PX1, K_lds, r32, hi, S.qr, ACT(t));                                             \
        finishSM(PY0, PY1, alY, l_reg, pa0, pa1, pa2, pa3); SBAR();                                                           \
        if ((t) + 1 < NT) { if constexpr (F32) { VMW(); SWRITE_KF(SB); SBAR(); SLOAD_F((const float*)Vh, KBASE((t) + 1)); }  \
                            SBAR(); }                                               \
        pv_tile<VB, SK>(o, vb0, pa0, pa1, pa2, pa3, ACT((t) - 1)); MASKT(PX0, PX1, (t)); partialSM(PX0, PX1, m_reg, mnX, alX);                                        \
        __syncthreads();                                                                                                      \
        if ((t) + 1 < NT) { VMW(); if constexpr (F32) { SWRITE_VF(SB); SBAR(); if ((t) + 2 < NT) SLOAD_F((const float*)Kh, KBASE((t) + 2)); } \
                            else { SWRITE_H(SB); } }                                                                          \
        RESC(alX); __syncthreads(); } while (0)
    for (int t = 1; t + 1 < NT; t += 2) {
        HALF_STEP(pB0, pB1, mnB, alB, pA0, pA1, alA, t, 1, 0, 0);
        HALF_STEP(pA0, pA1, mnA, alA, pB0, pB1, alB, t + 1, 0, 1, 1);
    }
    const bool even = (NT & 1) == 0;
    if (even) { SBAR(); qkt<1, SK>(pB0, pB1, K_lds, r32, hi, S.qr, ACT(NT - 1)); SBAR(); }
#define QROW(e) (nxt.Q + (size_t)(wid * QBLK + r32) * ZP + ((e) >> 1) * 16 + hi * 8 + ((e) & 1) * 4)
    if constexpr (F32) { SLOAD_F((const float*)nxt.K, kbn); SBAR();
#pragma unroll
        for (int e = 0; e < 8; ++e) S.tq[e] = *(const f32x4*)QROW(e); }
    else { SLOAD_H(nxt.K, (nxt.K + 1024), kbn); SBAR();
#pragma unroll
        for (int d0 = 0; d0 < 8; ++d0) S.qr[d0] = load8<TIn>(nxt.Q + (size_t)(wid * QBLK + r32) * ZP + d0 * 16 + hi * 8); }
    SBAR();
    finishSM(pA0, pA1, alA, l_reg, pa0, pa1, pa2, pa3); SBAR();
    if constexpr (F32) {
#pragma unroll
        for (int e = 8; e < 16; ++e) S.tq[e] = *(const f32x4*)QROW(e); SBAR(); }
#undef QROW
    pv_tile<0, SK>(o, vb0, pa0, pa1, pa2, pa3, ACT(even ? NT - 2 : NT - 1));
    if (even) { MASKT(pB0, pB1, NT - 1); partialSM(pB0, pB1, m_reg, mnB, alB); __syncthreads(); RESC(alB);
        finishSM(pB0, pB1, alB, l_reg, pa0, pa1, pa2, pa3); SBAR(); pv_tile<1, SK>(o, vb0, pa0, pa1, pa2, pa3, ACT(NT - 1)); }
    SBAR(); SEAM_K0();
    if (hi == 0) li_l[r32] = l_reg; asm volatile("s_waitcnt lgkmcnt(0)" ::: "memory");
    float rli[16];
#pragma unroll
    for (int r = 0; r < 16; ++r) rli[r] = __builtin_amdgcn_rcpf(li_l[crow(r, hi)]);
    TOut* Ow = cur.O + (size_t)(wid * QBLK) * OP;
#pragma unroll
    for (int r = 0; r < 16; ++r) { const int orow = crow(r, hi);
#pragma unroll
        for (int d0 = 0; d0 < 4; ++d0) { const float v = o[d0][r] * rli[r];
            if constexpr (same_t<TOut, float>::v) { Ow[(size_t)orow * OP + d0 * 32 + r32] = v; }
            else { const float vn = __shfl_xor(v, 1);
                   if ((r32 & 1) == 0) *(unsigned*)(Ow + (size_t)orow * OP + d0 * 32 + r32) = cvtpk(v, vn); } } }
    if constexpr (F32) {
#pragma unroll
        for (int d0 = 0; d0 < 8; ++d0) S.qr[d0] = pack8(S.tq[2 * d0], S.tq[2 * d0 + 1]); }
    __syncthreads();
#undef RESC
#undef KBASE
#undef ACT
#undef MASKT
#undef SEAM_K0
#undef HALF_STEP
}
#undef ROW
#undef VMW
#undef VMWN
#undef SLOAD_H
#undef SWRITE_HK
#undef SWRITE_HV
#undef SWRITE_H
#undef SLOAD_F
#undef SWRITE_KF
#undef SWRITE_VF


}
namespace mk {
#define LAS __attribute__((address_space(3)))
typedef unsigned short bf16;
typedef unsigned v4u __attribute__((ext_vector_type(4)));
typedef unsigned v2u __attribute__((ext_vector_type(2)));
typedef float f32x4 __attribute__((ext_vector_type(4)));
constexpr int S = 16384, DM = 2048, NIN = 10240, NINSRC = 10248, CWD = 1024, FF = 8192, NH = 8, FCOL = 6144;
constexpr float EPS = 1e-6f, SQRT_HD = 11.313708498984761f;
constexpr size_t MiB = 1u << 20;
constexpr size_t WS_CTR = 32 * 1024  , WS_RSS = 128 * 1024, WS_BAR = 16 * 1024, CTL_ZERO_BYTES = 64 * 1024, WS_NRM = 64 * 1024, WS_LOGF = 1 * MiB, WS_CS = 1 * MiB + 512 * 1024, WS_WIN = 2 * MiB, WS_WC = 42 * MiB, WS_WA = 46 * MiB, WS_WMIX = 50 * MiB, WS_W1 = 58 * MiB, WS_W2 = 90 * MiB;
constexpr size_t WS_Z = 128 * MiB, WS_XN = 448 * MiB, WS_CONVY = 512 * MiB, WS_ATTO = 544 * MiB, WS_RN2 = 576 * MiB, WS_END = 577 * MiB;
constexpr int LDS_BYTES = att::LDS_BYTES + 65536 + 128;
static_assert(LDS_BYTES >= pg8::STAGE_BYTES, "LDS");
constexpr int NTHR = 512, NWAVES = 8;

#define LDS_WAIT() asm volatile("s_waitcnt lgkmcnt(0)" ::: "memory")
__device__ __forceinline__ unsigned f2bf(float f) { unsigned u = __builtin_bit_cast(unsigned, f); return (u + 0x7fffu + ((u >> 16) & 1u)) >> 16; }
__device__ __forceinline__ unsigned pk2(float lo, float hi) { return f2bf(lo) | (f2bf(hi) << 16); }
__device__ __forceinline__ float wave_sum(float v) {
#pragma unroll
    for (int o = 1; o < 64; o <<= 1) v += __shfl_xor(v, o);
    return v;
}
__device__ __forceinline__ void transpose_item(const float* W, int ldw, int split, int K, int N, bf16* WT, LAS float* scr, int item, int lane) {
    const int nblk = N / 32, kb = item / nblk, nb = item % nblk, k0 = 64 * kb, n0 = 32 * nb, c0 = n0 + (n0 >= split ? 8 : 0);
#pragma unroll 8
    for (int i = 0; i < 32; ++i) { const int kk = 2 * i + (lane >> 5); scr[kk * 33 + (lane & 31)] = __builtin_nontemporal_load(W + (size_t)(k0 + kk) * ldw + c0 + (lane & 31)); }
    LDS_WAIT(); asm volatile("" ::: "memory");
    const int c = lane & 7;
#pragma unroll
    for (int j = 0; j < 4; ++j) { const int n = (lane >> 3) + 8 * j; const LAS float* s = scr + (8 * c) * 33 + n;
        v4u o; o.x = pk2(s[0 * 33], s[1 * 33]); o.y = pk2(s[2 * 33], s[3 * 33]); o.z = pk2(s[4 * 33], s[5 * 33]); o.w = pk2(s[6 * 33], s[7 * 33]);
        *(v4u*)(WT + (size_t)(n0 + n) * K + k0 + 8 * c) = o; }
    LDS_WAIT(); asm volatile("" ::: "memory");
}
__device__ __forceinline__ void rms_load(f32x4 (&v)[8], const float* xrow, int lane) {
    const f32x4* xr = (const f32x4*)xrow + lane;
#pragma unroll
    for (int j = 0; j < 8; ++j) v[j] = __builtin_nontemporal_load(xr + 64 * j);
}
template <bool OUT_BF16, bool LOGF>
__device__ __forceinline__ void rms_row(const f32x4 (&v)[8], const float* g, bf16* orow, float* frow, int lane, const LAS float* gwf, float* logf_out, const float* bfp) {
    float s = 0.f;
#pragma unroll
    for (int j = 0; j < 8; ++j) { s += (v[j].x * v[j].x + v[j].y * v[j].y) + (v[j].z * v[j].z + v[j].w * v[j].w); }
    const float rstd = 1.0f / sqrtf(wave_sum(s) * (1.0f / DM) + EPS);
    if (LOGF) {
        float mine = 0.f;
#pragma nounroll
        for (int jj = 0; jj < 8; ++jj) { float t = 0.f;
#pragma unroll
            for (int j = 0; j < 8; ++j) { const f32x4 w = *(const LAS f32x4*)(gwf + jj * DM + 256 * j + 4 * lane); t += (v[j].x * w.x + v[j].y * w.y) + (v[j].z * w.z + v[j].w * w.w); }
            t = wave_sum(t) * rstd; mine = (lane == jj) ? t : mine; }
        if (lane < 8) { const float z = mine + bfp[lane]; logf_out[lane] = fminf(z, 0.f) - __logf(1.0f + __expf(-fabsf(z))); }
    }
#pragma unroll
    for (int j = 0; j < 8; ++j) { const f32x4 gg = ((const f32x4*)g)[64 * j + lane]; const f32x4 y = v[j] * rstd * gg;
        if (OUT_BF16) { v2u o; o.x = pk2(y.x, y.y); o.y = pk2(y.z, y.w); ((v2u*)orow)[64 * j + lane] = o; }
        else __builtin_nontemporal_store(y, (f32x4*)frow + 64 * j + lane); }
}
__device__ __forceinline__ void cumsum_head(const float* logf, float* cs, int h, LAS float* sm, int tid) {
    const int lane = tid & 63, wave = tid >> 6;
    float v[32]; const float* p = logf + (size_t)(32 * tid) * NH + h; float s = 0.f;
#pragma unroll
    for (int i = 0; i < 32; ++i) { v[i] = p[i * NH]; }
#pragma unroll
    for (int i = 0; i < 32; ++i) { s += v[i]; }
    float inc = s;
#pragma unroll
    for (int o = 1; o < 64; o <<= 1) { const float n = __shfl_up(inc, o); if (lane >= o) inc += n; }
    if (lane == 63) sm[wave] = inc;
    __syncthreads();
    float wp = 0.f;
#pragma unroll
    for (int w = 0; w < 8; ++w) wp += (w < wave) ? sm[w] : 0.f;
    float run = wp + inc - s;
    float* o = cs + (size_t)h * S + 32 * tid;
#pragma unroll
    for (int i = 0; i < 32; i += 4) { f32x4 q; run += v[i]; q.x = run * SQRT_HD; run += v[i + 1]; q.y = run * SQRT_HD; run += v[i + 2]; q.z = run * SQRT_HD; run += v[i + 3]; q.w = run * SQRT_HD; *(f32x4*)(o + i) = q; }
    __syncthreads();
}
__device__ __forceinline__ void unpack8f(const v4u w, float (&f)[8]) {
    f[0] = __uint_as_float(w.x << 16); f[1] = __uint_as_float(w.x & 0xffff0000u); f[2] = __uint_as_float(w.y << 16); f[3] = __uint_as_float(w.y & 0xffff0000u);
    f[4] = __uint_as_float(w.z << 16); f[5] = __uint_as_float(w.z & 0xffff0000u); f[6] = __uint_as_float(w.w << 16); f[7] = __uint_as_float(w.w & 0xffff0000u);
}
__device__ __forceinline__ void conv_item(const bf16* z, const float* cw, bf16* convy, int item, int lane) {
    const int t0 = (item >> 1) * 16, c0 = (item & 1) * 512 + lane * 8;
    float w0[8], w1[8], w2[8], p2[8], p1[8];
#pragma unroll
    for (int e = 0; e < 8; ++e) { w0[e] = cw[c0 + e]; w1[e] = cw[CWD + c0 + e]; w2[e] = cw[2 * CWD + c0 + e]; p2[e] = 0.f; p1[e] = 0.f; }
    if (t0 >= 2) {
        float a[8], b[8];
        unpack8f(*(const v4u*)(z + (size_t)(t0 - 2) * NIN + CWD + c0), a); unpack8f(*(const v4u*)(z + (size_t)(t0 - 2) * NIN + 2 * CWD + c0), b);
#pragma unroll
        for (int e = 0; e < 8; ++e) p2[e] = a[e] * b[e];
        unpack8f(*(const v4u*)(z + (size_t)(t0 - 1) * NIN + CWD + c0), a); unpack8f(*(const v4u*)(z + (size_t)(t0 - 1) * NIN + 2 * CWD + c0), b);
#pragma unroll
        for (int e = 0; e < 8; ++e) p1[e] = a[e] * b[e];
    }
#pragma nounroll
    for (int rb = 0; rb < 16; rb += 8) {
        v4u xd[8], xa[8], xb[8];
#pragma unroll
        for (int q = 0; q < 8; ++q) { const bf16* zr = z + (size_t)(t0 + rb + q) * NIN + c0; xd[q] = *(const v4u*)(zr); xa[q] = *(const v4u*)(zr + CWD); xb[q] = *(const v4u*)(zr + 2 * CWD); }
#pragma unroll
        for (int q = 0; q < 8; ++q) { float a[8], b[8], d[8], y[8];
            unpack8f(xd[q], d); unpack8f(xa[q], a); unpack8f(xb[q], b);
#pragma unroll
            for (int e = 0; e < 8; ++e) { const float pc = a[e] * b[e]; y[e] = d[e] * (w0[e] * p2[e] + w1[e] * p1[e] + w2[e] * pc); p2[e] = p1[e]; p1[e] = pc; }
            v4u o; o.x = pk2(y[0], y[1]); o.y = pk2(y[2], y[3]); o.z = pk2(y[4], y[5]); o.w = pk2(y[6], y[7]);
            *(v4u*)(convy + (size_t)(t0 + rb + q) * CWD + c0) = o; }
    }
}

#define XB_TMO      128
#define XB_XCNT(j)  (256  + 64 * (j))
#define XB_XSUB(j)  (1280 + 64 * (j))
#define XB_XGEN(j)  (2304 + 64 * (j))
#define XB_TOP      3328
#define XB_TOPGEN   3392
#define XCD_BAR_WORDS 3456
#define XB_SPIN_CAP (1u << 18)

__device__ __forceinline__ unsigned xb_ld(unsigned* p)              { return __hip_atomic_load(p, __ATOMIC_RELAXED, __HIP_MEMORY_SCOPE_AGENT); }
__device__ __forceinline__ unsigned xb_add(unsigned* p, unsigned v) { return __hip_atomic_fetch_add(p, v, __ATOMIC_RELAXED, __HIP_MEMORY_SCOPE_AGENT); }
__device__ __forceinline__ unsigned xb_xcc_id() { return (unsigned)__builtin_amdgcn_s_getreg((3 << 11) | 20) & 0xFu; }
#define XB_SPIN(cond, bar) do { unsigned _sp = 0; while (cond) { __builtin_amdgcn_s_sleep(1); \
    if ((++_sp & 255u) == 0u) { if (xb_ld(&(bar)[XB_TMO])) break; if (_sp > XB_SPIN_CAP) { atomicAdd(&(bar)[XB_TMO], 1u); break; } } } } while (0)

struct XcdBarrier {
    unsigned* bar; unsigned x;
    volatile LAS unsigned* st;
};

__device__ __forceinline__ XcdBarrier xcd_barrier_post(unsigned* bar, volatile LAS unsigned* st) {
    XcdBarrier b; b.bar = bar; b.x = xb_xcc_id(); b.st = st;
    if (threadIdx.x == 0) (void)xb_add(&bar[XB_XCNT(b.x)], 1u);
    return b;
}
__device__ __forceinline__ void xcd_barrier_complete(unsigned* bar, unsigned x, unsigned& nloc, unsigned& nx) {
    const unsigned G = gridDim.x * gridDim.y * gridDim.z;
    unsigned sum, cnt, mine, sp = 0u;
    for (;;) {
        sum = 0u; cnt = 0u; mine = 0u;
#pragma unroll
        for (unsigned j = 0; j < 16; ++j) { const unsigned c = xb_ld(&bar[XB_XCNT(j)]); sum += c; cnt += (c > 0u) ? 1u : 0u; mine = (j == x) ? c : mine; }
        if (sum == G) break;
        __builtin_amdgcn_s_sleep(1);
        if ((++sp & 255u) == 0u) { if (xb_ld(&bar[XB_TMO])) break; if (sp > XB_SPIN_CAP) { atomicAdd(&bar[XB_TMO], 1u); break; } }
    }
    nloc = mine > 0u ? mine : 1u; nx = cnt > 0u ? cnt : 1u;
}

__device__ __forceinline__ void xcd_barrier(const XcdBarrier& b) {
    asm volatile("s_waitcnt vmcnt(0)" ::: "memory");
    __syncthreads();
    if (threadIdx.x == 0) {
        unsigned* bar = b.bar;
        __builtin_amdgcn_s_waitcnt(0);
        unsigned nloc = b.st[0], nx = b.st[1];
        if (nloc == 0u) { xcd_barrier_complete(bar, b.x, nloc, nx); b.st[0] = nloc; b.st[1] = nx; }
        const unsigned old = xb_add(&bar[XB_XSUB(b.x)], 1u);
        const unsigned gen = old / nloc;
        if (old + 1u == (gen + 1u) * nloc) {
            __builtin_amdgcn_fence(__ATOMIC_RELEASE, "agent");
            asm volatile("s_waitcnt vmcnt(0)" ::: "memory");
            const unsigned og = xb_add(&bar[XB_TOP], 1u);
            const unsigned tg = og / nx;
            if (og + 1u == (tg + 1u) * nx) xb_add(&bar[XB_TOPGEN], 1u);
            else XB_SPIN(xb_ld(&bar[XB_TOPGEN]) == tg, bar);
            __builtin_amdgcn_fence(__ATOMIC_ACQUIRE, "agent");
            xb_add(&bar[XB_XGEN(b.x)], 1u);
            asm volatile("s_waitcnt vmcnt(0)" ::: "memory");
        } else {
            XB_SPIN(xb_ld(&bar[XB_XGEN(b.x)]) == gen, bar);
            __builtin_amdgcn_fence(__ATOMIC_ACQUIRE, "agent");
            asm volatile("s_waitcnt vmcnt(0)" ::: "memory");
        }
    }
    __syncthreads();
}

__device__ __forceinline__ int compute_jlo(const float* csh, const float* rq, const float* rk, int qb_in, int* sm, int tid0) {
    int t = tid0; asm volatile("" : "+v"(t)); int qb = qb_in; asm volatile("" : "+s"(qb));
    if (t == 0) { sm[0] = 4 * qb; sm[1] = 0; sm[3] = 0; }
    float kn = 0.f, qn = (t < 256) ? rq[qb * 256 + t] : 0.f;
    const int nk = (qb + 1) * 256;
#pragma unroll
    for (int j = 0; j < 8; ++j) { if (j * 2048 < nk) { const f32x4 v = ((const f32x4*)rk)[j * NTHR + t]; kn = fmaxf(kn, fmaxf(fmaxf(v.x, v.y), fmaxf(v.z, v.w))); } }
#define JLO_SW(o) do { kn = fmaxf(kn, __int_as_float(__builtin_amdgcn_ds_swizzle(__float_as_int(kn), 0x1f | ((o) << 10)))); qn = fmaxf(qn, __int_as_float(__builtin_amdgcn_ds_swizzle(__float_as_int(qn), 0x1f | ((o) << 10)))); } while (0)
    JLO_SW(1); JLO_SW(2); JLO_SW(4); JLO_SW(8); JLO_SW(16);
#undef JLO_SW
    __syncthreads();
    if ((t & 31) == 0) { atomicMax((unsigned*)&sm[1], __float_as_uint(kn)); atomicMax((unsigned*)&sm[3], __float_as_uint(qn)); }
    __syncthreads();
    const float K2 = __uint_as_float((unsigned)sm[1]), Q2 = __uint_as_float((unsigned)sm[3]);
    const float qk2 = 2.0f * sqrtf(Q2 * K2) * 1.01f, c0 = csh[qb * 256];
    if (t < 4 * qb) { const float ce = csh[64 * t + 63]; if (!((qk2 + c0 - ce) <= -110.0f * SQRT_HD)) atomicMin(&sm[0], t); }
    __syncthreads();
    const int j = sm[0];
    __syncthreads();
    return j;
}

struct Args { const float* in[13]; float* out; unsigned char* ws; };

__global__ void __launch_bounds__(NTHR, 2) fwd_megakernel(Args args) {
    extern __shared__ __attribute__((aligned(16))) unsigned char lds[];
    cg::grid_group grid = cg::this_grid();
    LAS unsigned char* L = (LAS unsigned char*)lds;
    const int tid0 = threadIdx.x, wave = __builtin_amdgcn_readfirstlane(tid0 >> 6);
#define LAUNDER_TID() int tid = tid0; asm volatile("" : "+v"(tid)); const int lane = tid & 63
    const int G = gridDim.x, bid = blockIdx.x, gw = bid * NWAVES + wave, NGW = G * NWAVES;
    unsigned char* ws = args.ws;
    float* rn2 = (float*)(ws + WS_RN2);
    float* logf = (float*)(ws + WS_LOGF); float* cs = (float*)(ws + WS_CS);
    bf16* Win_t = (bf16*)(ws + WS_WIN); bf16* Wc_t = (bf16*)(ws + WS_WC); bf16* Wa_t = (bf16*)(ws + WS_WA); bf16* Wmix_t = (bf16*)(ws + WS_WMIX);
    bf16* W1_t = (bf16*)(ws + WS_W1); bf16* W2_t = (bf16*)(ws + WS_W2);
    bf16* Z = (bf16*)(ws + WS_Z); bf16* XN = (bf16*)(ws + WS_XN); bf16* CONVY = (bf16*)(ws + WS_CONVY); bf16* ATTO = (bf16*)(ws + WS_ATTO);
    bf16* XG = (bf16*)(ws + WS_Z + 256 * MiB);
    float* rowss = (float*)(ws + WS_RSS);
    float* xres = args.out;
    volatile LAS unsigned* bst = (volatile LAS unsigned*)(L + att::LDS_BYTES + 65536 + 64);
    if (tid0 < 2) bst[tid0] = 0u;
    __syncthreads();
    const XcdBarrier xbar = xcd_barrier_post((unsigned*)(ws + WS_BAR), bst);
#ifdef EXTRA_SYNCS
#define GRID_SYNC() do { xcd_barrier(xbar); } while (0)
#else
#define GRID_SYNC() do { xcd_barrier(xbar); } while (0)
#endif

#pragma nounroll
    for (int l = 0; l < 2; ++l) {
        const float* xin = (l == 0) ? args.in[0] : (const float*)xres;
        const float* g_mix = args.in[1] + (size_t)l * DM; const float* w_in = args.in[2] + (size_t)l * DM * NINSRC;
        const float* b_f = args.in[3] + l * NH; const float* b_gate = args.in[4] + (size_t)l * 2 * DM; const float* conv_w = args.in[5] + (size_t)l * 3 * CWD;
        const float* w_c = args.in[6] + (size_t)l * CWD * DM; const float* w_a = args.in[7] + (size_t)l * CWD * DM; const float* w_mix = args.in[8] + (size_t)l * DM * DM;
        const float* g_mlp = args.in[9] + (size_t)l * DM; const float* w1 = args.in[10] + (size_t)l * DM * FF; const float* w2 = args.in[11] + (size_t)l * FF * DM;

#ifndef REP_P0
#define REP_P0 1
#endif
#pragma nounroll
        for (int rep_ = 0; rep_ < REP_P0; ++rep_) {
            if (rep_) __syncthreads();
            LAUNDER_TID();
            for (int b = bid; b < (16 * S) / (2 * NTHR); b += G) { rn2[b * 2 * NTHR + tid] = 0.f; rn2[b * 2 * NTHR + NTHR + tid] = 0.f; }
            if (bid == 1 % G) { for (int i = tid; i < S; i += NTHR) rowss[i] = 0.f; }
            LAS float* scr = (LAS float*)(L + wave * 16384);
            constexpr int I_IN = (DM / 64) * (NIN / 32), I_C = (CWD / 64) * (DM / 32), I_MIX = (DM / 64) * (DM / 32), I_1 = (DM / 64) * (FF / 32), I_2 = (FF / 64) * (DM / 32);
            constexpr int NITEMS = I_IN + 2 * I_C + I_MIX + I_1 + I_2;
            for (int it = gw; it < NITEMS; it += NGW) {
                int r = it;
                if (r < I_IN) { transpose_item(w_in, NINSRC, FCOL, DM, NIN, Win_t, scr, r, lane); continue; } r -= I_IN;
                if (r < I_C) { transpose_item(w_c, DM, 1 << 30, CWD, DM, Wc_t, scr, r, lane); continue; } r -= I_C;
                if (r < I_C) { transpose_item(w_a, DM, 1 << 30, CWD, DM, Wa_t, scr, r, lane); continue; } r -= I_C;
                if (r < I_MIX) { transpose_item(w_mix, DM, 1 << 30, DM, DM, Wmix_t, scr, r, lane); continue; } r -= I_MIX;
                if (r < I_1) { transpose_item(w1, FF, 1 << 30, DM, FF, W1_t, scr, r, lane); continue; } r -= I_1;
                transpose_item(w2, DM, 1 << 30, FF, DM, W2_t, scr, r, lane);
            }
            __syncthreads();
            LAS float* gwf = (LAS float*)L;
#pragma unroll
            for (int i_ = 0; i_ < DM / NTHR; ++i_) { const int k = tid + i_ * NTHR; const float* wp = w_in + (size_t)k * NINSRC + FCOL; const f32x4 a = *(const f32x4*)wp, b = *(const f32x4*)(wp + 4); const float gk = g_mix[k];
                gwf[0 * DM + k] = gk * a.x; gwf[1 * DM + k] = gk * a.y; gwf[2 * DM + k] = gk * a.z; gwf[3 * DM + k] = gk * a.w;
                gwf[4 * DM + k] = gk * b.x; gwf[5 * DM + k] = gk * b.y; gwf[6 * DM + k] = gk * b.z; gwf[7 * DM + k] = gk * b.w; }
            __syncthreads();
            {   f32x4 rv[8], rn[8]; rms_load(rv, xin + (size_t)gw * DM, lane);
                for (int m = gw; m < S; m += NGW) {
                    const int mn = (m + NGW < S) ? m + NGW : m; rms_load(rn, xin + (size_t)mn * DM, lane);
                    rms_row<true, true>(rv, g_mix, XN + (size_t)m * DM, nullptr, lane, gwf, logf + (size_t)m * NH, b_f);
#pragma unroll
                    for (int j = 0; j < 8; ++j) rv[j] = rn[j]; } }
        }
        if (l == 0) { __syncthreads(); grid.sync(); } else GRID_SYNC();

        {
            { LAUNDER_TID(); if (bid < NH) cumsum_head(logf, cs, bid, (LAS float*)L, tid); }
            pg8::Gemm g{XN, Win_t, S, NIN, DM, DM}; pg8::StaticOrder So; So.init(S, NIN, G, bid);
            pg8::Epi<pg8::EP_INPROJ> E{Z, NIN, nullptr, 0, nullptr, (3 * CWD) / 256  , nullptr, nullptr, b_gate, FCOL / 256, rn2};
#ifndef REP_P1
#define REP_P1 1
#endif
#pragma nounroll
            for (int rep_ = 0; rep_ < REP_P1; ++rep_)
            pg8::gemm_phase<pg8::Epi<pg8::EP_INPROJ>, pg8::StaticOrder, true, true>(L, g, So, E);
        }
        GRID_SYNC();

#ifndef REP_P2
#define REP_P2 1
#endif
#pragma nounroll
        for (int rep_ = 0; rep_ < REP_P2; ++rep_) {
            if (rep_) GRID_SYNC();
            LAUNDER_TID();
            using abf = att::bf16; typedef att::BlockRef<abf, abf> BR;
            char* al = (char*)lds; float* csl = (float*)((char*)lds + att::LDS_BYTES);
            const abf* Qb = (const abf*)Z + 3 * CWD; const abf* Kb = (const abf*)Z + 4 * CWD;
            constexpr int NQB = S / att::QB, NITEM = NH * (NQB / 2);
            unsigned ord = 0u;
            {   float ce[NH];
#pragma unroll
                for (int h = 0; h < NH; ++h) ce[h] = cs[(size_t)h * S + S - 1];
#pragma unroll
                for (int hh = 0; hh < NH; ++hh) { int rr = 0;
#pragma unroll
                    for (int g2 = 0; g2 < NH; ++g2) rr += (ce[g2] > ce[hh] || (ce[g2] == ce[hh] && g2 < hh)) ? 1 : 0;
                    ord |= (unsigned)hh << (4 * rr); }
                ord = __builtin_amdgcn_readfirstlane(ord); }
            {
                unsigned* actr = (unsigned*)(ws + WS_CTR) + 64 * l + 16;
                int* smi2 = (int*)((char*)lds + att::LDS_BYTES + 65536);
                int Ls = (G % 8 == 0) ? (bid % 8) * (G / 8) + bid / 8 : bid; bool dyn = false;
#define MK_REF(r, Lx, ps) do { const int i_ = (Lx), rk_ = i_ >> 6, qb_ = (NQB - 1) - (i_ & (NQB - 1)), h_ = (int)((ord >> (4 * rk_)) & 7u); \
                    (r).Q = Qb + h_ * 128 + (size_t)qb_ * att::QB * NIN; (r).O = (abf*)ATTO + h_ * 128 + (size_t)qb_ * att::QB * CWD; (r).K = Kb + h_ * 128; (r).P0 = qb_ * att::QB; (r).C = cs + (size_t)h_ * S; (r).JLO = compute_jlo((r).C, rn2 + (size_t)h_ * S, rn2 + (size_t)(NH + h_) * S, qb_, (int*)((char*)lds + att::LDS_BYTES + 65536), tid0); } while (0)
                att::Seam<abf> Sm;
                for (;;) {
                    int pos;
                    if (!dyn) { pos = Ls; if (pos >= NITEM) { dyn = true; continue; } Ls += G; }
                    else { int t4 = tid0; asm volatile("" : "+v"(t4)); if (t4 == 0) smi2[2] = (int)atomicAdd(actr, 1u);
                        __syncthreads(); pos = NITEM + __builtin_amdgcn_readfirstlane(smi2[2]); __syncthreads();
                        if (pos >= 2 * NITEM) break; }
                    BR cur; MK_REF(cur, pos, 0);
                    att::causal_swa_prime<abf, abf>(cur, S, al, Sm);
                    { const int n4 = (cur.P0 + att::QB) / 4; int t2 = tid0; asm volatile("" : "+v"(t2)); for (int i = cur.JLO * 16 + t2; i < n4; i += NTHR) ((f32x4*)csl)[i] = ((const f32x4*)cur.C)[i]; }
                    __syncthreads();
                    att::causal_swa_block<abf, abf>(cur, cur, S, S, al, Sm, csl);
                }
#undef MK_REF
            }
            {   unsigned* ctr = (unsigned*)(ws + WS_CTR) + 64 * l; int* smi = (int*)((char*)lds + att::LDS_BYTES + 65536);
                int t3 = tid0; asm volatile("" : "+v"(t3)); const int lane3 = t3 & 63;
                for (;;) {
                    if (t3 == 0) smi[2] = (int)atomicAdd(ctr, 8u);
                    __syncthreads();
                    const int base = __builtin_amdgcn_readfirstlane(smi[2]);
                    __syncthreads();
                    if (base >= (S / 16) * 2) break;
                    conv_item(Z, conv_w, CONVY, base + wave, lane3);
                }
            }
        }
        GRID_SYNC();

        {
            pg8::Gemm g{CONVY, Wc_t, S, DM, CWD, CWD}; pg8::StaticOrder So; So.init(S, DM, G, bid);
            pg8::Epi<pg8::EP_T1> E{Z, NIN, Z + FCOL, NIN, nullptr, 0, nullptr, nullptr, nullptr, 0, nullptr};
            pg8::gemm_phase<pg8::Epi<pg8::EP_T1>, pg8::StaticOrder, true, true>(L, g, So, E);
        }
        {
            pg8::Gemm g{ATTO, Wa_t, S, DM, CWD, CWD}; pg8::StaticOrder So; So.init(S, DM, G, bid);
            pg8::Epi<pg8::EP_MERGE> E{XN, DM, Z + FCOL + DM, NIN, Z, NIN, nullptr, nullptr, nullptr, 0, nullptr};
            pg8::gemm_phase<pg8::Epi<pg8::EP_MERGE>, pg8::StaticOrder, true, true>(L, g, So, E);
        }
        GRID_SYNC();

        {
            pg8::Gemm g{XN, Wmix_t, S, DM, DM, DM}; pg8::StaticOrder So; So.init(S, DM, G, bid);
            pg8::Epi<pg8::EP_RESID_N> E{XG, DM, nullptr, 0, nullptr, 0, xin, xres, g_mlp, 0, rowss};
            pg8::gemm_phase<pg8::Epi<pg8::EP_RESID_N>, pg8::StaticOrder, true, true>(L, g, So, E);
        }
        GRID_SYNC();


        {
            pg8::Gemm g{XG, W1_t, S, FF, DM, DM}; pg8::StaticOrder So; So.init(S, FF, G, bid);
            pg8::Epi<pg8::EP_RELU2> E{Z, FF, nullptr, 0, nullptr, 0, nullptr, nullptr, nullptr, 0, rowss};
#ifndef REP_P7
#define REP_P7 1
#endif
#pragma nounroll
            for (int rep_ = 0; rep_ < REP_P7; ++rep_)
            pg8::gemm_phase<pg8::Epi<pg8::EP_RELU2>, pg8::StaticOrder, true, true>(L, g, So, E);
        }
        GRID_SYNC();

        {
            pg8::Gemm g{Z, W2_t, S, DM, FF, FF}; pg8::StaticOrder So; So.init(S, DM, G, bid);
            pg8::Epi<pg8::EP_RESID> E{nullptr, 0, nullptr, 0, nullptr, 0, xres, xres, nullptr, 0, nullptr};
            pg8::gemm_phase<pg8::Epi<pg8::EP_RESID>, pg8::StaticOrder, true, true>(L, g, So, E);
        }
        GRID_SYNC();
    }
#ifdef EXTRA_SYNCS
#pragma nounroll
    for (int i = 0; i < EXTRA_SYNCS; ++i) GRID_SYNC();
#endif
    {   LAUNDER_TID(); f32x4 rv[8], rn[8]; rms_load(rv, xres + (size_t)gw * DM, lane);
        for (int m = gw; m < S; m += NGW) {
            const int mn = (m + NGW < S) ? m + NGW : m; rms_load(rn, xres + (size_t)mn * DM, lane);
            rms_row<false, false>(rv, args.in[12], nullptr, xres + (size_t)m * DM, lane, nullptr, nullptr, nullptr);
#pragma unroll
            for (int j = 0; j < 8; ++j) rv[j] = rn[j]; } }
}
}

extern "C" void kernel_launch(void* const* d_in, const int* in_sizes, int n_in, void* d_out, int out_size, void* d_ws, size_t ws_size, hipStream_t stream) {
    static int grid = 0;
    if (grid == 0) {
        if (n_in != 13 || out_size != mk::S * mk::DM || ws_size < mk::WS_END) { fprintf(stderr, "kernel_launch: unexpected shapes (n_in %d out %d ws %zu)\n", n_in, out_size, ws_size); grid = -1; return; }
        int dev = 0, cus = 0, per_cu = 0;
        (void)hipGetDevice(&dev); (void)hipDeviceGetAttribute(&cus, hipDeviceAttributeMultiprocessorCount, dev);
        if (hipFuncSetAttribute((const void*)mk::fwd_megakernel, hipFuncAttributeMaxDynamicSharedMemorySize, mk::LDS_BYTES) != hipSuccess) { fprintf(stderr, "kernel_launch: hipFuncSetAttribute failed\n"); grid = -1; return; }
        if (hipOccupancyMaxActiveBlocksPerMultiprocessor(&per_cu, (const void*)mk::fwd_megakernel, mk::NTHR, mk::LDS_BYTES) != hipSuccess || per_cu < 1) { fprintf(stderr, "kernel_launch: occupancy query says %d\n", per_cu); per_cu = 1; }
        (void)hipGetLastError();
        grid = cus * per_cu;
    }
    if (grid < 0) return;
    if (hipMemsetAsync(d_ws, 0, mk::CTL_ZERO_BYTES, stream) != hipSuccess) { fprintf(stderr, "kernel_launch: hipMemsetAsync failed\n"); return; }
    mk::Args a{};
    for (int i = 0; i < 13; ++i) a.in[i] = (const float*)d_in[i];
    a.out = (float*)d_out; a.ws = (unsigned char*)d_ws;
    void* kargs[] = {&a};
    hipError_t e = hipLaunchCooperativeKernel((const void*)mk::fwd_megakernel, dim3(grid), dim3(mk::NTHR), kargs, mk::LDS_BYTES, stream);
    if (e != hipSuccess) fprintf(stderr, "kernel_launch: cooperative launch failed: %s (grid %d)\n", hipGetErrorString(e), grid);
}
```

```cpp
#include <hip/hip_runtime.h>
#include <hip/hip_cooperative_groups.h>
#include <hip/hip_bf16.h>
#include <cstdio>
#include <cstdint>
#include <cmath>
namespace cg = cooperative_groups;

namespace pg8 {
#define PG8_LAS __attribute__((address_space(3)))
typedef unsigned short bf16_t;
typedef short bf16x8 __attribute__((ext_vector_type(8)));
typedef float f32x4 __attribute__((ext_vector_type(4)));
typedef unsigned u32x4 __attribute__((ext_vector_type(4)));
constexpr int BM = 256, BK = 64, HALF = 128, HTB = HALF * BK * 2  , STAGE_BYTES = 8 * HTB, NXCD = 8, WGM = 2;

__host__ __device__ __forceinline__ int lds_byte(int r, int c) { const int st = (r >> 4) * 2 + (c >> 5), rr = r & 15, cc = c & 31, ob = rr * 64 + cc * 2; return st * 1024 + (ob ^ (((ob >> 9) & 1) << 5)); }
__host__ __device__ __forceinline__ void stage_rc(int b, int& R, int& C) { const int st = b / 1024, sb = b % 1024, swz = sb ^ (((sb >> 9) & 1) << 5); R = (st >> 1) * 16 + swz / 64; C = (st & 1) * 32 + (swz % 64) / 2; }
__host__ __device__ __forceinline__ int perm32(int rho) { const int n = rho >> 4, i = rho & 15; return 8 * (i >> 2) + 4 * n + (i & 3); }

struct Unit { int pm, pn; };
struct Gemm { const bf16_t* A; const bf16_t* Bt; int M, N, K, lda; };

struct StaticOrder {
    int nM, nN, nwg, G, c;
    __host__ __device__ void init(int M, int N, int G_, int c_) { nM = M / BM; nN = N / BM; nwg = nM * nN; G = G_; c = c_; }
    __host__ __device__ bool next(int i, Unit& u) const {
        const long L = (long)i * G + c; if (L >= nwg) return false;
        int wgid = (int)L; { const int q = nwg / NXCD, r = nwg % NXCD, xcd = wgid % NXCD, off = wgid / NXCD; wgid = (xcd < r ? xcd * (q + 1) : r * (q + 1) + (xcd - r) * q) + off; }
        const int nig = WGM * nN, gid = wgid / nig, fm = gid * WGM, gsz = (nM - fm) < WGM ? (nM - fm) : WGM;
        u.pm = fm + ((wgid % nig) % gsz); u.pn = (wgid % nig) / gsz; return true;
    }
    __device__ __forceinline__ void a_ready(const Unit&) const {}
    __device__ __forceinline__ void done(const Unit&) const {}
};


__device__ __forceinline__ unsigned cvt_pk_bf16(float lo, float hi) { unsigned r; asm volatile("v_cvt_pk_bf16_f32 %0, %1, %2" : "=v"(r) : "v"(lo), "v"(hi)); return r; }
__device__ __forceinline__ void unpack8(const u32x4 w, f32x4& a, f32x4& b) {
    a[0] = __uint_as_float(w.x << 16); a[1] = __uint_as_float(w.x & 0xffff0000u); a[2] = __uint_as_float(w.y << 16); a[3] = __uint_as_float(w.y & 0xffff0000u);
    b[0] = __uint_as_float(w.z << 16); b[1] = __uint_as_float(w.z & 0xffff0000u); b[2] = __uint_as_float(w.w << 16); b[3] = __uint_as_float(w.w & 0xffff0000u);
}
__device__ __forceinline__ float sum_fq(float v) {
    v += __int_as_float(__builtin_amdgcn_ds_swizzle(__float_as_int(v), 0x1f | (16 << 10)));
    const auto rr = __builtin_amdgcn_permlane32_swap(__float_as_uint(v), __float_as_uint(v), false, false);
    return __uint_as_float(rr[0]) + __uint_as_float(rr[1]);
}
__device__ __forceinline__ f32x4 sigmoid4(f32x4 v) { f32x4 o;
#pragma unroll
    for (int i = 0; i < 4; ++i) o[i] = __builtin_amdgcn_rcpf(1.0f + __expf(-v[i]));
    return o; }
enum { EP_INPROJ = 0, EP_T1 = 1, EP_MERGE = 2, EP_RESID = 3, EP_RELU2 = 4, EP_RESID_N = 5 };
template <int MODE> struct Epi {
    static constexpr bool PERM = true, AFTER_DRAIN = false;
    bf16_t* O; int ldc; const bf16_t* Gt; int ldg; const bf16_t* T; int ldt; const float* X; float* XO; const float* bias; int gate_tile0; float* RS;
    __device__ __forceinline__ void operator()(const f32x4 (&acc)[2][2][4][2], const Unit& u, int wr, int wc, int fr, int fq) const {
        run<false>(acc, u, wr, wc, fr, fq);
    }
    template <bool GATE> __device__ __forceinline__ void run(const f32x4 (&acc)[2][2][4][2], const Unit& u, int wr, int wc, int fr, int fq) const {
        const int row0 = u.pm * BM + wr * 64 + fr, col0 = u.pn * BM + wc * 32 + 8 * fq;
        const bool gate = (MODE == EP_INPROJ) && (u.pn >= gate_tile0);
        f32x4 bv[2][2];
#pragma unroll
        for (int bj = 0; bj < 2; ++bj)
#pragma unroll
            for (int n = 0; n < 2; ++n) { bv[bj][n] = (f32x4){0.f, 0.f, 0.f, 0.f}; if (MODE == EP_INPROJ) bv[bj][n] = *(const f32x4*)(bias + (gate ? col0 - gate_tile0 * BM : 0) + bj * HALF + 4 * n); }
        if (MODE == EP_INPROJ) asm volatile("" : "+v"(bv[0][0]), "+v"(bv[0][1]), "+v"(bv[1][0]), "+v"(bv[1][1]));
        if (MODE == EP_RESID_N) {
#pragma unroll
            for (int bj = 0; bj < 2; ++bj)
#pragma unroll
                for (int n = 0; n < 2; ++n) bv[bj][n] = *(const f32x4*)(bias + col0 + bj * HALF + 4 * n);
        }
        float rsc[2][4];
#pragma unroll
        for (int ai = 0; ai < 2; ++ai)
#pragma unroll
            for (int m = 0; m < 4; ++m) rsc[ai][m] = (MODE == EP_RELU2) ? __builtin_amdgcn_rcpf(RS[row0 + ai * HALF + m * 16] * (1.0f / 2048.0f) + 1e-6f) : 1.0f;
#pragma unroll
        for (int ai = 0; ai < 2; ++ai)
#pragma unroll
            for (int m = 0; m < 4; ++m) { const size_t r = (size_t)(row0 + ai * HALF + m * 16); float ss = 0.f;
#pragma unroll
                for (int bj = 0; bj < 2; ++bj) { const int c = col0 + bj * HALF; f32x4 v0 = acc[ai][bj][m][0], v1 = acc[ai][bj][m][1];
                    if (MODE == EP_INPROJ) { if (gate) { v0 = sigmoid4(v0 + bv[bj][0]); v1 = sigmoid4(v1 + bv[bj][1]); } }
                    if (MODE == EP_T1 || MODE == EP_MERGE) { f32x4 g0, g1; unpack8(*(const u32x4*)(Gt + r * ldg + c), g0, g1); v0 = v0 * g0; v1 = v1 * g1; }
                    if (MODE == EP_MERGE) { f32x4 t0, t1; unpack8(*(const u32x4*)(T + r * ldt + c), t0, t1); v0 = v0 + t0; v1 = v1 + t1; }
                    if (MODE == EP_RELU2) {
#pragma unroll
                        for (int i = 0; i < 4; ++i) { const float a = fmaxf(v0[i], 0.f), b = fmaxf(v1[i], 0.f); v0[i] = a * a * rsc[ai][m]; v1[i] = b * b * rsc[ai][m]; } }
                    if (MODE == EP_RESID_N) { const float* xp = X + r * 2048 + c; float* op = XO + r * 2048 + c;
                        const f32x4 y0 = *(const f32x4*)xp + v0, y1 = *(const f32x4*)(xp + 4) + v1; *(f32x4*)op = y0; *(f32x4*)(op + 4) = y1;
                        ss += (y0[0] * y0[0] + y0[1] * y0[1]) + (y0[2] * y0[2] + y0[3] * y0[3]) + (y1[0] * y1[0] + y1[1] * y1[1]) + (y1[2] * y1[2] + y1[3] * y1[3]);
                        v0 = y0 * bv[bj][0]; v1 = y1 * bv[bj][1]; }
                    if (MODE == EP_RESID) { const float* xp = X + r * 2048 + c; float* op = XO + r * 2048 + c;
                        const f32x4 x0 = *(const f32x4*)xp, x1 = *(const f32x4*)(xp + 4); *(f32x4*)op = x0 + v0; *(f32x4*)(op + 4) = x1 + v1; }
                    else { u32x4 w; w.x = cvt_pk_bf16(v0[0], v0[1]); w.y = cvt_pk_bf16(v0[2], v0[3]); w.z = cvt_pk_bf16(v1[0], v1[1]); w.w = cvt_pk_bf16(v1[2], v1[3]);
                        *(u32x4*)(O + r * ldc + c) = w; } }
                if (MODE == EP_INPROJ) { if (u.pn >= ldt && u.pn < ldt + 8) {
#pragma unroll
                    for (int bj = 0; bj < 2; ++bj) { const f32x4 a = acc[ai][bj][m][0], b = acc[ai][bj][m][1];
                        float s2 = (a[0] * a[0] + a[1] * a[1]) + (a[2] * a[2] + a[3] * a[3]) + (b[0] * b[0] + b[1] * b[1]) + (b[2] * b[2] + b[3] * b[3]);
                        s2 = sum_fq(s2);
                        if (fq == 0) atomicAdd(RS + (size_t)((u.pn - ldt) * 2 + bj) * 16384 + r, s2); } } }
                if (MODE == EP_RESID_N) { ss = sum_fq(ss); if (fq == 0) atomicAdd(RS + r, ss); }
                if (MODE == EP_T1 || MODE == EP_MERGE || MODE == EP_RESID || MODE == EP_RESID_N) asm volatile("" ::: "memory"); }
    }
};

template <class Epi, class Sched, bool ALIGN_EPI = false, bool SP2 = false>
__device__ __forceinline__ void gemm_phase(PG8_LAS unsigned char* lds, const Gemm g, const Sched& S, const Epi& E) {
    int tid_ = threadIdx.x; asm volatile("" : "+v"(tid_));
    const int tid = tid_, wid = __builtin_amdgcn_readfirstlane(tid >> 6), lane = tid & 63, wr = wid >> 2, wc = wid & 3, fr = lane & 15, fq = lane >> 4;
    const int K = g.K, nt = K / BK, lda = g.lda;
    unsigned voffA[2], voffB[2];
#pragma unroll
    for (int i = 0; i < 2; ++i) { int R, C; stage_rc(tid * 16 + i * 8192, R, C); const int Rb = Epi::PERM ? ((R & ~31) + perm32(R & 31)) : R;
        voffA[i] = (unsigned)(R * lda + C) * 2u; voffB[i] = (unsigned)(Rb * K + C) * 2u; }
    const size_t kstep = (size_t)(BK * 2);
    const size_t hstepA = (size_t)HALF * lda * 2, hstepB = (size_t)HALF * K * 2;
    const size_t tstepA = 2 * hstepA, tstepB = 2 * hstepB;
    const unsigned ldsw = (unsigned)wid * 1024u;
    const int aoff = lds_byte(wr * 64 + fr, fq * 8), boff = lds_byte(wc * 32 + fr, fq * 8);
#define PG8_SA(b, h) (((b) * 2 + (h)) * HTB)
#define PG8_SB(b, h) ((4 + (b) * 2 + (h)) * HTB)
#ifdef EXP_DMA2
#define PG8_NREP 2
#else
#define PG8_NREP 1
#endif
#define PG8_STAGE(bufoff, gbase, voff) do { _Pragma("unroll") for (int _i = 0; _i < 2; ++_i) _Pragma("unroll") for (int _r = 0; _r < PG8_NREP; ++_r) \
        __builtin_amdgcn_global_load_lds((const unsigned*)((const char*)(gbase) + (voff)[_i]), (PG8_LAS unsigned*)(lds + (bufoff) + ldsw + _i * 8192), 16, 0, 0); } while (0)
#ifdef EXP_LDS2
#define PG8_DUP(addr) do { bf16x8 _d; asm volatile("ds_read_b128 %0, %1" : "=v"(_d) : "v"((unsigned)(addr)) : "memory"); } while (0)
#else
#define PG8_DUP(addr) do { } while (0)
#endif
#define PG8_LDA(dst, b, h) do { _Pragma("unroll") for (int m = 0; m < 4; ++m) _Pragma("unroll") for (int k = 0; k < 2; ++k) { dst[m][k] = *(const PG8_LAS bf16x8*)(lds + PG8_SA(b, h) + aoff + m * 2048 + k * 1024); PG8_DUP((unsigned)(uintptr_t)(lds + PG8_SA(b, h) + aoff + m * 2048 + k * 1024)); } } while (0)
#define PG8_LDB(dst, b, h) do { _Pragma("unroll") for (int n = 0; n < 2; ++n) _Pragma("unroll") for (int k = 0; k < 2; ++k) { dst[n][k] = *(const PG8_LAS bf16x8*)(lds + PG8_SB(b, h) + boff + n * 2048 + k * 1024); PG8_DUP((unsigned)(uintptr_t)(lds + PG8_SB(b, h) + boff + n * 2048 + k * 1024)); } } while (0)
#define PG8_MMA(ai, bj, At, Bt) do { __builtin_amdgcn_s_setprio(1); _Pragma("unroll") for (int m = 0; m < 4; ++m) _Pragma("unroll") for (int n = 0; n < 2; ++n) _Pragma("unroll") for (int k = 0; k < 2; ++k) \
        acc[ai][bj][m][n] = __builtin_amdgcn_mfma_f32_16x16x32_bf16(Bt[n][k], At[m][k], acc[ai][bj][m][n], 0, 0, 0); __builtin_amdgcn_s_setprio(0); } while (0)
#ifdef EXP_DMA2
#define PG8_WAIT_V(n) do { if ((n) == 0) asm volatile("s_waitcnt vmcnt(0)" ::: "memory"); else if ((n) == 2) asm volatile("s_waitcnt vmcnt(4)" ::: "memory"); else if ((n) == 4) asm volatile("s_waitcnt vmcnt(8)" ::: "memory"); \
    else if ((n) == 6) asm volatile("s_waitcnt vmcnt(12)" ::: "memory"); else asm volatile("s_waitcnt vmcnt(16)" ::: "memory"); } while (0)
#else
#define PG8_WAIT_V(n) asm volatile("s_waitcnt vmcnt(" #n ")" ::: "memory")
#endif
#define PG8_WAIT_L(n) asm volatile("s_waitcnt lgkmcnt(" #n ")" ::: "memory")
#define PG8_BAR __builtin_amdgcn_s_barrier()
#define PG8_SCHED __builtin_amdgcn_sched_barrier(0)
    Unit cur, nxt; int ui = 0;
    if (!S.next(0, cur)) return;
    f32x4 acc[2][2][4][2];
#pragma unroll
    for (int a = 0; a < 2; ++a)
#pragma unroll
        for (int b = 0; b < 2; ++b)
#pragma unroll
            for (int m = 0; m < 4; ++m)
#pragma unroll
                for (int n = 0; n < 2; ++n) acc[a][b][m][n] = (f32x4){0.f, 0.f, 0.f, 0.f};
    bf16x8 At[4][2], B0[2][2], B1[2][2];
    const char* cA = (const char*)g.A + (size_t)cur.pm * tstepA; const char* cB = (const char*)g.Bt + (size_t)cur.pn * tstepB;
    S.a_ready(cur);
    if constexpr (SP2) {
        PG8_STAGE(PG8_SB(0, 0), cB, voffB); PG8_STAGE(PG8_SB(0, 1), cB + hstepB, voffB); PG8_STAGE(PG8_SA(0, 0), cA, voffA); PG8_STAGE(PG8_SA(0, 1), cA + hstepA, voffA);
        if (wr == 1) PG8_BAR;
        PG8_WAIT_V(2); PG8_BAR;
        PG8_STAGE(PG8_SB(1, 0), cB + kstep, voffB); PG8_STAGE(PG8_SA(1, 0), cA + kstep, voffA); PG8_STAGE(PG8_SB(1, 1), cB + hstepB + kstep, voffB);
        PG8_WAIT_V(6); PG8_BAR;
    } else {
        PG8_STAGE(PG8_SB(0, 0), cB, voffB); PG8_STAGE(PG8_SA(0, 0), cA, voffA); PG8_STAGE(PG8_SB(0, 1), cB + hstepB, voffB); PG8_STAGE(PG8_SA(0, 1), cA + hstepA, voffA);
        if (wr == 1) PG8_BAR;
        PG8_WAIT_V(4); PG8_BAR;
        PG8_STAGE(PG8_SB(1, 0), cB + kstep, voffB); PG8_STAGE(PG8_SA(1, 0), cA + kstep, voffA); PG8_STAGE(PG8_SB(1, 1), cB + hstepB + kstep, voffB);
        PG8_WAIT_V(6); PG8_BAR;
    }
    for (;;) {
        const bool has_next = S.next(ui + 1, nxt);
        const char* nA = has_next ? (const char*)g.A + (size_t)nxt.pm * tstepA : cA; const char* nB = has_next ? (const char*)g.Bt + (size_t)nxt.pn * tstepB : cB;
        for (int t = 0; t < nt; t += 2) {
            const bool last = (t == nt - 2);
            const char* a1 = cA + (size_t)(t + 1) * kstep;
            const char* a2 = last ? nA : cA + (size_t)(t + 2) * kstep; const char* b2 = last ? nB : cB + (size_t)(t + 2) * kstep;
            const char* a3 = a2 + kstep; const char* b3 = b2 + kstep;
            if (last && has_next) S.a_ready(nxt);
            if constexpr (SP2) {
#ifdef TEST_DRAIN
            if (Epi::PERM && sizeof(Epi) && TEST_DRAIN) PG8_WAIT_V(0);
#endif
            PG8_LDB(B0, 0, 0); PG8_LDB(B1, 0, 1); PG8_SCHED; PG8_LDA(At, 0, 0); PG8_STAGE(PG8_SA(1, 1), a1 + hstepA, voffA);
            PG8_WAIT_V(8); PG8_WAIT_L(0); PG8_BAR; PG8_MMA(0, 0, At, B0); PG8_MMA(0, 1, At, B1); PG8_BAR; PG8_SCHED;
            PG8_LDA(At, 0, 1); PG8_STAGE(PG8_SB(0, 0), b2, voffB); PG8_STAGE(PG8_SB(0, 1), b2 + hstepB, voffB); PG8_STAGE(PG8_SA(0, 0), a2, voffA);
            PG8_WAIT_V(8); PG8_WAIT_L(0); PG8_BAR; PG8_MMA(1, 0, At, B0); PG8_MMA(1, 1, At, B1); PG8_BAR; PG8_SCHED;
            PG8_LDB(B0, 1, 0); PG8_LDB(B1, 1, 1); PG8_SCHED; PG8_LDA(At, 1, 0); PG8_STAGE(PG8_SA(0, 1), a2 + hstepA, voffA);
            PG8_WAIT_V(8); PG8_WAIT_L(0); PG8_BAR; PG8_MMA(0, 0, At, B0); PG8_MMA(0, 1, At, B1); PG8_BAR; PG8_SCHED;
            PG8_LDA(At, 1, 1); PG8_STAGE(PG8_SB(1, 0), b3, voffB); PG8_STAGE(PG8_SB(1, 1), b3 + hstepB, voffB); PG8_STAGE(PG8_SA(1, 0), a3, voffA);
            PG8_WAIT_V(8); PG8_WAIT_L(0); PG8_BAR; PG8_MMA(1, 0, At, B0); PG8_MMA(1, 1, At, B1); PG8_BAR; PG8_SCHED;
            } else {
            PG8_LDB(B0, 0, 0); PG8_SCHED; PG8_LDA(At, 0, 0); PG8_STAGE(PG8_SA(1, 1), a1 + hstepA, voffA);
            PG8_WAIT_L(8); PG8_BAR; PG8_WAIT_L(0); PG8_MMA(0, 0, At, B0); PG8_BAR; PG8_SCHED;
            PG8_LDB(B1, 0, 1); PG8_STAGE(PG8_SB(0, 0), b2, voffB);
            PG8_BAR; PG8_WAIT_L(0); PG8_MMA(0, 1, At, B1); PG8_BAR;
            PG8_LDA(At, 0, 1); PG8_STAGE(PG8_SA(0, 0), a2, voffA);
            PG8_BAR; PG8_WAIT_L(0); PG8_MMA(1, 0, At, B0); PG8_BAR; PG8_SCHED;
            PG8_STAGE(PG8_SB(0, 1), b2 + hstepB, voffB);
            PG8_WAIT_V(6); PG8_BAR; PG8_MMA(1, 1, At, B1); PG8_BAR;
            PG8_LDB(B0, 1, 0); PG8_SCHED; PG8_LDA(At, 1, 0); PG8_STAGE(PG8_SA(0, 1), a2 + hstepA, voffA);
            PG8_WAIT_L(8); PG8_BAR; PG8_WAIT_L(0); PG8_MMA(0, 0, At, B0); PG8_BAR; PG8_SCHED;
            PG8_LDB(B1, 1, 1); PG8_STAGE(PG8_SB(1, 0), b3, voffB);
            PG8_BAR; PG8_WAIT_L(0); PG8_MMA(0, 1, At, B1); PG8_BAR;
            PG8_LDA(At, 1, 1); PG8_STAGE(PG8_SA(1, 0), a3, voffA);
            PG8_BAR; PG8_WAIT_L(0); PG8_MMA(1, 0, At, B0); PG8_BAR; PG8_SCHED;
            PG8_STAGE(PG8_SB(1, 1), b3 + hstepB, voffB);
            PG8_WAIT_V(6); PG8_BAR; PG8_MMA(1, 1, At, B1); PG8_BAR;
            }
        }
        if constexpr (ALIGN_EPI) { if (wr == 0) PG8_BAR; }
        if constexpr (!Epi::AFTER_DRAIN) { E(acc, cur, wr, wc, fr, fq); S.done(cur); }
        if (!has_next) break;
#pragma unroll
        for (int a = 0; a < 2; ++a)
#pragma unroll
            for (int b = 0; b < 2; ++b)
#pragma unroll
                for (int m = 0; m < 4; ++m)
#pragma unroll
                    for (int n = 0; n < 2; ++n) acc[a][b][m][n] = (f32x4){0.f, 0.f, 0.f, 0.f};
        cur = nxt; cA = nA; cB = nB; ++ui;
        if constexpr (ALIGN_EPI) { if (wr == 1) PG8_BAR; }
    }
    PG8_WAIT_V(0);
    if constexpr (!ALIGN_EPI) { if (wr == 0) PG8_BAR; }
    PG8_BAR;
    if constexpr (Epi::AFTER_DRAIN) { E.fused(acc, cur, wr, wc, fr, fq, lds, wid, lane); S.done(cur); }
#undef PG8_SA
#undef PG8_SB
#undef PG8_STAGE
#undef PG8_LDA
#undef PG8_LDB
#undef PG8_MMA
#undef PG8_WAIT_V
#undef PG8_WAIT_L
#undef PG8_BAR
#undef PG8_SCHED
}
}
namespace att {
constexpr int B = 1, H = 8, HKV = 8, SQ = 16384, SKV = 16384, D = 128, QOFF = 0, WINDOW = SKV;
constexpr int OP = 1024;
constexpr int ZP = 10240;
constexpr float THR = 8.f;
constexpr bool WSKIP = false;
constexpr float SCALE = 0.08838834764831845f;
constexpr int NW = 8, QBLK = 32, KVBLK = 64, QB = NW * QBLK;
constexpr int SHM_V = KVBLK * D * 2, SHM_K = KVBLK * D * 2;
constexpr int LDS_BYTES = 2 * SHM_V + 2 * SHM_K + NW * 64 * 4;

using bf16 = __hip_bfloat16;
typedef short bf16x8 __attribute__((ext_vector_type(8)));
typedef short s16x4 __attribute__((ext_vector_type(4)));
typedef float f32x16 __attribute__((ext_vector_type(16)));
typedef float f32x4 __attribute__((ext_vector_type(4)));
typedef unsigned u32x4 __attribute__((ext_vector_type(4)));
template <class A, class Bt> struct same_t { static constexpr bool v = false; };
template <class A> struct same_t<A, A> { static constexpr bool v = true; };

#define KSWZ(row, colB) ((row) * 256 + ((colB) ^ (((row) & 7) << 4)))
#define SBAR() __builtin_amdgcn_sched_barrier(0)
__device__ __forceinline__ int v_st(int k, int c) { const int kk = (k & ~0xC) | ((k & 4) << 1) | ((k & 8) >> 1); return ((kk >> 3) * 4 + (c >> 5)) * 512 + ((kk & 7) * 32 + (c & 31)) * 2; }
__device__ __forceinline__ int v_rd_base(int lane) { return ((lane & 3) << 3) | (((lane >> 2) & 3) << 6) | (((lane >> 4) & 1) << 5) | (((lane >> 5) & 1) << 8); }
constexpr int v_rd_off(int d0, int ks, int half) { return d0 * 512 + ks * 4096 + half * 2048; }
__device__ __forceinline__ int crow(int r, int hi) { return (r & 3) + 8 * (r >> 2) + 4 * hi; }
__device__ __forceinline__ unsigned cvtpk(float lo, float hi) {
    unsigned r; asm volatile("v_cvt_pk_bf16_f32 %0, %1, %2" : "=v"(r) : "v"(lo), "v"(hi)); return r;
}
__device__ __forceinline__ bf16x8 pack8(f32x4 a, f32x4 b) {
    u32x4 w = {cvtpk(a[0], a[1]), cvtpk(a[2], a[3]), cvtpk(b[0], b[1]), cvtpk(b[2], b[3])};
    return *reinterpret_cast<bf16x8*>(&w);
}
template <class T> __device__ __forceinline__ bf16x8 load8(const T* p) {
    if constexpr (same_t<T, float>::v) { return pack8(*(const f32x4*)p, *(const f32x4*)(p + 4)); }
    else { return *reinterpret_cast<const bf16x8*>(p); }
}
__device__ __forceinline__ void mask_tile(f32x16& p0, f32x16& p1, int dq, unsigned W) {
    const float NEG = -__builtin_inff();
#pragma unroll
    for (int r = 0; r < 16; ++r) {
        const int c = (r & 3) + 8 * (r >> 2);
        if ((unsigned)(dq - c) >= W) p0[r] = NEG;
        if ((unsigned)(dq - c - 32) >= W) p1[r] = NEG;
    }
}
__device__ __forceinline__ void bias_tile(f32x16& p0, f32x16& p1, const float* cst, int hi) {
#pragma unroll
    for (int i = 0; i < 4; ++i) { const f32x4 a = *(const f32x4*)(cst + 8 * i + 4 * hi);
#pragma unroll
        for (int j = 0; j < 4; ++j) p0[4 * i + j] -= a[j]; }
    SBAR();
#pragma unroll
    for (int i = 0; i < 4; ++i) { const f32x4 b = *(const f32x4*)(cst + 32 + 8 * i + 4 * hi);
#pragma unroll
        for (int j = 0; j < 4; ++j) p1[4 * i + j] -= b[j]; }
}
__device__ __forceinline__ void partialSM(f32x16& p0, f32x16& p1, float& m_reg, float& mn, float& alpha) {
    float pmax = p0[0]; for (int r = 1; r < 16; ++r) pmax = fmaxf(pmax, p0[r]); for (int r = 0; r < 16; ++r) pmax = fmaxf(pmax, p1[r]);
    { auto rr = __builtin_amdgcn_permlane32_swap(__float_as_uint(pmax), __float_as_uint(pmax), false, false);
      pmax = fmaxf(__uint_as_float(rr[0]), __uint_as_float(rr[1])); }
    constexpr float C2 = 1.4426950408889634f * SCALE;
    if (__builtin_expect(__all((pmax - m_reg) * SCALE <= THR), 1)) { mn = m_reg; alpha = 1.f; }
    else { mn = fmaxf(m_reg, pmax); alpha = __builtin_amdgcn_exp2f((m_reg - mn) * C2); m_reg = mn; }
    const float mnL = -mn * C2;
    for (int r = 0; r < 16; ++r) p0[r] = fmaf(p0[r], C2, mnL); for (int r = 0; r < 16; ++r) p1[r] = fmaf(p1[r], C2, mnL);
    for (int r = 0; r < 16; ++r) p0[r] = __builtin_amdgcn_exp2f(p0[r]);
}
__device__ __forceinline__ void finishSM(f32x16& p0, f32x16& p1, float alpha, float& l_reg, bf16x8& pa0, bf16x8& pa1, bf16x8& pa2, bf16x8& pa3) {
    for (int r = 0; r < 16; ++r) p1[r] = __builtin_amdgcn_exp2f(p1[r]);
    float ps = 0; for (int r = 0; r < 16; ++r) ps += p0[r]; for (int r = 0; r < 16; ++r) ps += p1[r];
    { auto rr = __builtin_amdgcn_permlane32_swap(__float_as_uint(ps), __float_as_uint(ps), false, false);
      ps = __uint_as_float(rr[0]) + __uint_as_float(rr[1]); }
    l_reg = l_reg * alpha + ps;
#define PK4(P, B_, OUT) do { unsigned a0 = cvtpk(P[B_+0], P[B_+1]), a1 = cvtpk(P[B_+2], P[B_+3]);                          \
        unsigned b0 = cvtpk(P[B_+4], P[B_+5]), b1 = cvtpk(P[B_+6], P[B_+7]);                                             \
        auto r0 = __builtin_amdgcn_permlane32_swap(a0, b0, false, false); auto r1 = __builtin_amdgcn_permlane32_swap(a1, b1, false, false); \
        u32x4 w = {r0[0], r1[0], r0[1], r1[1]}; OUT = *reinterpret_cast<bf16x8*>(&w); } while (0)
    PK4(p0, 0, pa0); PK4(p0, 8, pa1); PK4(p1, 0, pa2); PK4(p1, 8, pa3);
#undef PK4
}
template <int KB, bool SK>
__device__ __forceinline__ void qkt(f32x16& p0, f32x16& p1, const char* K_lds, int r32, int hi, const bf16x8* qr, bool act) {
    if (SK && !act) { const float NEG = -__builtin_inff();
#pragma unroll
        for (int r = 0; r < 16; ++r) { p0[r] = NEG; p1[r] = NEG; } return; }
    p0 = f32x16{}; p1 = f32x16{};
    const char* kb[4];
#pragma unroll
    for (int dd = 0; dd < 4; ++dd) kb[dd] = K_lds + KB * SHM_K + KSWZ(r32, (dd * 16 + hi * 8) * 2);
#pragma unroll
    for (int d0 = 0; d0 < 8; ++d0) { const char* a = kb[d0 & 3] + (d0 >> 2) * 128;
        bf16x8 b0 = *reinterpret_cast<const bf16x8*>(a);
        bf16x8 b1 = *reinterpret_cast<const bf16x8*>(a + 32 * 256);
        p0 = __builtin_amdgcn_mfma_f32_32x32x16_bf16(b0, qr[d0], p0, 0, 0, 0);
        p1 = __builtin_amdgcn_mfma_f32_32x32x16_bf16(b1, qr[d0], p1, 0, 0, 0); }
}
template <int VB, bool SK>
__device__ __forceinline__ void pv_tile(f32x16* o, int vb0, bf16x8 pa0, bf16x8 pa1, bf16x8 pa2, bf16x8 pa3, bool act) {
    if (SK && !act) return;
#define TRRD(dst, off) asm volatile("ds_read_b64_tr_b16 %0, %1 offset:%2" : "=&v"(dst) : "v"(vb0), "i"(off) : "memory")
#define PV_D0(d0) do { s16x4 l0, l1, l2, l3, h0, h1, h2, h3; constexpr int b_ = VB * SHM_V + v_rd_off(d0, 0, 0);     \
        TRRD(l0, b_); TRRD(h0, b_ + 2048); TRRD(l1, b_ + 4096); TRRD(h1, b_ + 6144); TRRD(l2, b_ + 8192); TRRD(h2, b_ + 10240); TRRD(l3, b_ + 12288); TRRD(h3, b_ + 14336); \
        asm volatile("s_waitcnt lgkmcnt(0)" ::: "memory"); SBAR();                 \
        o[d0] = __builtin_amdgcn_mfma_f32_32x32x16_bf16(pa0, (bf16x8){l0[0], l0[1], l0[2], l0[3], h0[0], h0[1], h0[2], h0[3]}, o[d0], 0, 0, 0);   \
        o[d0] = __builtin_amdgcn_mfma_f32_32x32x16_bf16(pa1, (bf16x8){l1[0], l1[1], l1[2], l1[3], h1[0], h1[1], h1[2], h1[3]}, o[d0], 0, 0, 0);   \
        o[d0] = __builtin_amdgcn_mfma_f32_32x32x16_bf16(pa2, (bf16x8){l2[0], l2[1], l2[2], l2[3], h2[0], h2[1], h2[2], h2[3]}, o[d0], 0, 0, 0);   \
        o[d0] = __builtin_amdgcn_mfma_f32_32x32x16_bf16(pa3, (bf16x8){l3[0], l3[1], l3[2], l3[3], h3[0], h3[1], h3[2], h3[3]}, o[d0], 0, 0, 0); } while (0)
    PV_D0(0); PV_D0(1); PV_D0(2); PV_D0(3);
#undef PV_D0
#undef TRRD
}

template <class TIn, class TOut> struct BlockRef { const TIn* Q; const TIn* K; TOut* O; int P0; const float* C; int JLO; };
template <class TIn> struct Seam {
    bf16x8 qr[8];
    bf16x8 st_v0, st_v1, st_k0, st_k1; f32x4 sf0, sf1, sf2, sf3;
    f32x4 tq[16];
};
__device__ __forceinline__ int swa_jlo(int P0, int W) { const int lowk = P0 - W + 1; return lowk > 0 ? lowk / KVBLK : 0; }
#define ROW(p, k0, rr) ((p) + (size_t)((k0) + (rr)) * ZP + sc)
#define VMW() asm volatile("s_waitcnt vmcnt(0)" ::: "memory")
#define VMWN(n) asm volatile("s_waitcnt vmcnt(%0)" :: "i"(n) : "memory")
#define SLOAD_H(Kp, Vp, k0) do { S.st_v0 = load8<TIn>(ROW(Vp, k0, sr)); S.st_v1 = load8<TIn>(ROW(Vp, k0, 32 + sr));              \
                         S.st_k0 = load8<TIn>(ROW(Kp, k0, sr)); S.st_k1 = load8<TIn>(ROW(Kp, k0, 32 + sr)); } while (0)
#define SWRITE_HK(bf) do { *(bf16x8*)(K_lds + (bf) * SHM_K + kws) = S.st_k0; *(bf16x8*)(K_lds + (bf) * SHM_K + kws + 32 * 256) = S.st_k1; } while (0)
#define SWRITE_HV(bf) do { *(bf16x8*)(V_lds + (bf) * SHM_V + vst0) = S.st_v0; *(bf16x8*)(V_lds + (bf) * SHM_V + vst1) = S.st_v1; } while (0)
#define SWRITE_H(bf) do { SWRITE_HV(bf); SWRITE_HK(bf); } while (0)
#define SLOAD_F(p, k0) do { S.sf0 = *(const f32x4*)ROW(p, k0, sr); S.sf1 = *(const f32x4*)(ROW(p, k0, sr) + 4);                \
                            S.sf2 = *(const f32x4*)ROW(p, k0, 32 + sr); S.sf3 = *(const f32x4*)(ROW(p, k0, 32 + sr) + 4); } while (0)
#define SWRITE_KF(bf) do { *(bf16x8*)(K_lds + (bf) * SHM_K + kws) = pack8(S.sf0, S.sf1); *(bf16x8*)(K_lds + (bf) * SHM_K + kws + 32 * 256) = pack8(S.sf2, S.sf3); } while (0)
#define SWRITE_VF(bf) do { *(bf16x8*)(V_lds + (bf) * SHM_V + vst0) = pack8(S.sf0, S.sf1); *(bf16x8*)(V_lds + (bf) * SHM_V + vst1) = pack8(S.sf2, S.sf3); } while (0)
template <class TIn, class TOut>
__device__ __forceinline__ void causal_swa_prime(const BlockRef<TIn, TOut>& cur, int W, char* lds, Seam<TIn>& S) {
    constexpr bool F32 = same_t<TIn, float>::v;
    int tid_ = threadIdx.x; asm volatile("" : "+v"(tid_));
    const int tid = tid_, wid = __builtin_amdgcn_readfirstlane(tid >> 6), lane = tid & 63, r32 = lane & 31, hi = lane >> 5;
    const int sr = tid >> 4, sc = (tid & 15) * 8, kws = KSWZ(sr, sc * 2); char* K_lds = lds + 2 * SHM_V;
    const int kb0 = cur.JLO * KVBLK;
    for (int d0 = 0; d0 < 8; ++d0) S.qr[d0] = load8<TIn>(cur.Q + (size_t)(wid * QBLK + r32) * ZP + d0 * 16 + hi * 8);
    if constexpr (F32) { SLOAD_F((const float*)cur.K, kb0); VMW(); SWRITE_KF(0); SBAR(); SLOAD_F((const float*)(cur.K + 1024), kb0); }
    else { SLOAD_H(cur.K, (cur.K + 1024), kb0); VMW(); SWRITE_HK(0); }
    __syncthreads();
}
template <class TIn, class TOut>
__device__ __forceinline__ void causal_swa_block(const BlockRef<TIn, TOut>& cur, const BlockRef<TIn, TOut>& nxt, int skv, int W, char* lds, Seam<TIn>& S, const float* csl) {
    constexpr bool F32 = same_t<TIn, float>::v;
    int tid_ = threadIdx.x; asm volatile("" : "+v"(tid_));
    const int tid = tid_, wid = __builtin_amdgcn_readfirstlane(tid >> 6), lane = tid & 63, r32 = lane & 31, hi = lane >> 5;
    const int j_lo = cur.JLO;
    int j_hi = (cur.P0 + QB - 1) / KVBLK + 1; if (j_hi > skv / KVBLK) j_hi = skv / KVBLK;
    const int NT = j_hi - j_lo;
    const int kbn = nxt.JLO * KVBLK;
    const int qlo = cur.P0 + wid * QBLK, qm = qlo + r32 - 4 * hi;
    char* V_lds = lds; char* K_lds = lds + 2 * SHM_V;
    float* ws = (float*)(lds + 2 * SHM_V + 2 * SHM_K) + wid * 64; float* li_l = ws, * al_l = ws + 32;
    float m_reg = -1e30f, l_reg = 0; f32x16 o[4] = {};
    const int sr = tid >> 4, sc = (tid & 15) * 8, vst0 = v_st(sr, sc), vst1 = v_st(32 + sr, sc), kws = KSWZ(sr, sc * 2);
    const int vb0 = (int)(uintptr_t)V_lds + v_rd_base(lane);
    const TIn* Kh = cur.K; const TIn* Vh = (cur.K + 1024);
#define RESC(a) do { if (__any((a) < 1.f)) { if (hi == 0) al_l[r32] = (a); asm volatile("s_waitcnt lgkmcnt(0)" ::: "memory");              \
                     for (int d_ = 0; d_ < 4; ++d_) for (int r = 0; r < 16; ++r) o[d_][r] *= al_l[crow(r, hi)]; } } while (0)
#define KBASE(t) ((j_lo + (t)) * KVBLK)
#define ACT(t) (KBASE(t) <= qlo + QBLK - 1 && KBASE(t) + KVBLK - 1 >= qlo - W + 1)
#define MASKT(P0_, P1_, t) do { const int kb_ = KBASE(t); bias_tile(P0_, P1_, csl + kb_, hi); if ((!SK || ACT(t)) && (kb_ + KVBLK - 1 > qlo || kb_ <= qlo + QBLK - 1 - W)) mask_tile(P0_, P1_, qm - kb_, (unsigned)W); } while (0)
    constexpr int NQL = F32 ? 16 : 8;
    constexpr bool SK = WSKIP && !F32;
#define SEAM_K0() do { VMWN(NQL); if constexpr (F32) { SWRITE_KF(0); SBAR(); SLOAD_F((const float*)(nxt.K + 1024), kbn); } else { SWRITE_HK(0); } SBAR(); } while (0)
    f32x16 pA0, pA1, pB0, pB1; float mnA, mnB, alA, alB; bf16x8 pa0, pa1, pa2, pa3;
    if constexpr (F32) { VMW(); SWRITE_VF(0); SBAR(); } else { SWRITE_HV(0); SBAR(); }
    if (NT > 1) { if constexpr (F32) SLOAD_F((const float*)Kh, KBASE(1)); else SLOAD_H(Kh, Vh, KBASE(1)); }
    SBAR(); qkt<0, SK>(pA0, pA1, K_lds, r32, hi, S.qr, ACT(0));
    if constexpr (F32) { if (NT > 1) { VMW(); SWRITE_KF(1); SBAR(); SLOAD_F((const float*)Vh, KBASE(1)); } }
    MASKT(pA0, pA1, 0); partialSM(pA0, pA1, m_reg, mnA, alA);
    if (NT > 1) { VMW(); if constexpr (F32) { SWRITE_VF(1); SBAR(); if (NT > 2) SLOAD_F((const float*)Kh, KBASE(2)); } else SWRITE_H(1); }
    __syncthreads();
#define HALF_STEP(PX0, PX1, mnX, alX, PY0, PY1, alY, t, KB, VB, SB) do {                                                      \
        if constexpr (!F32) { if ((t) + 1 < NT) SLOAD_H(Kh, Vh, KBASE((t) + 1)); }     \
        SBAR(); qkt<KB, SK>(PX0, PX1, K_lds, r32, hi, S.qr, ACT(t));                                             \
        finishSM(PY0, PY1, alY, l_reg, pa0, pa1, pa2, pa3); SBAR();                                                           \
        if ((t) + 1 < NT) { if constexpr (F32) { VMW(); SWRITE_KF(SB); SBAR(); SLOAD_F((const float*)Vh, KBASE((t) + 1)); }  \
                            SBAR(); }                                               \
        pv_tile<VB, SK>(o, vb0, pa0, pa1, pa2, pa3, ACT((t) - 1)); MASKT(PX0, PX1, (t)); partialSM(PX0, PX1, m_reg, mnX, alX);                                        \
        __syncthreads();                                                                                                      \
        if ((t) + 1 < NT) { VMW(); if constexpr (F32) { SWRITE_VF(SB); SBAR(); if ((t) + 2 < NT) SLOAD_F((const float*)Kh, KBASE((t) + 2)); } \
                            else { SWRITE_H(SB); } }                                                                          \
        RESC(alX); __syncthreads(); } while (0)
    for (int t = 1; t + 1 < NT; t += 2) {
        HALF_STEP(pB0, pB1, mnB, alB, pA0, pA1, alA, t, 1, 0, 0);
        HALF_STEP(pA0, pA1, mnA, alA, pB0, pB1, alB, t + 1, 0, 1, 1);
    }
    const bool even = (NT & 1) == 0;
    if (even) { SBAR(); qkt<1, SK>(pB0, pB1, K_lds, r32, hi, S.qr, ACT(NT - 1)); SBAR(); }
#define QROW(e) (nxt.Q + (size_t)(wid * QBLK + r32) * ZP + ((e) >> 1) * 16 + hi * 8 + ((e) & 1) * 4)
    if constexpr (F32) { SLOAD_F((const float*)nxt.K, kbn); SBAR();
#pragma unroll
        for (int e = 0; e < 8; ++e) S.tq[e] = *(const f32x4*)QROW(e); }
    else { SLOAD_H(nxt.K, (nxt.K + 1024), kbn); SBAR();
#pragma unroll
        for (int d0 = 0; d0 < 8; ++d0) S.qr[d0] = load8<TIn>(nxt.Q + (size_t)(wid * QBLK + r32) * ZP + d0 * 16 + hi * 8); }
    SBAR();
    finishSM(pA0, pA1, alA, l_reg, pa0, pa1, pa2, pa3); SBAR();
    if constexpr (F32) {
#pragma unroll
        for (int e = 8; e < 16; ++e) S.tq[e] = *(const f32x4*)QROW(e); SBAR(); }
#undef QROW
    pv_tile<0, SK>(o, vb0, pa0, pa1, pa2, pa3, ACT(even ? NT - 2 : NT - 1));
    if (even) { MASKT(pB0, pB1, NT - 1); partialSM(pB0, pB1, m_reg, mnB, alB); __syncthreads(); RESC(alB);
        finishSM(pB0, pB1, alB, l_reg, pa0, pa1, pa2, pa3); SBAR(); pv_tile<1, SK>(o, vb0, pa0, pa1, pa2, pa3, ACT(NT - 1)); }
    SBAR(); SEAM_K0();
    if (hi == 0) li_l[r32] = l_reg; asm volatile("s_waitcnt lgkmcnt(0)" ::: "memory");
    float rli[16];
#pragma unroll
    for (int r = 0; r < 16; ++r) rli[r] = __builtin_amdgcn_rcpf(li_l[crow(r, hi)]);
    TOut* Ow = cur.O + (size_t)(wid * QBLK) * OP;
#pragma unroll
    for (int r = 0; r < 16; ++r) { const int orow = crow(r, hi);
#pragma unroll
        for (int d0 = 0; d0 < 4; ++d0) { const float v = o[d0][r] * rli[r];
            if constexpr (same_t<TOut, float>::v) { Ow[(size_t)orow * OP + d0 * 32 + r32] = v; }
            else { const float vn = __shfl_xor(v, 1);
                   if ((r32 & 1) == 0) *(unsigned*)(Ow + (size_t)orow * OP + d0 * 32 + r32) = cvtpk(v, vn); } } }
    if constexpr (F32) {
#pragma unroll
        for (int d0 = 0; d0 < 8; ++d0) S.qr[d0] = pack8(S.tq[2 * d0], S.tq[2 * d0 + 1]); }
    __syncthreads();
#undef RESC
#undef KBASE
#undef ACT
#undef MASKT
#undef SEAM_K0
#undef HALF_STEP
}
#undef ROW
#undef VMW
#undef VMWN
#undef SLOAD_H
#undef SWRITE_HK
#undef SWRITE_HV
#undef SWRITE_H
#undef SLOAD_F
#undef SWRITE_KF
#undef SWRITE_VF


}
namespace mk {
#define LAS __attribute__((address_space(3)))
typedef unsigned short bf16;
typedef unsigned v4u __attribute__((ext_vector_type(4)));
typedef unsigned v2u __attribute__((ext_vector_type(2)));
typedef float f32x4 __attribute__((ext_vector_type(4)));
constexpr int S = 16384, DM = 2048, NIN = 10240, NINSRC = 10248, CWD = 1024, FF = 8192, NH = 8, FCOL = 6144;
constexpr float EPS = 1e-6f, SQRT_HD = 11.313708498984761f;
constexpr size_t MiB = 1u << 20;
constexpr size_t WS_CTR = 32 * 1024  , WS_RSS = 128 * 1024, WS_BAR = 16 * 1024, CTL_ZERO_BYTES = 64 * 1024, WS_NRM = 64 * 1024, WS_LOGF = 1 * MiB, WS_CS = 1 * MiB + 512 * 1024, WS_WIN = 2 * MiB, WS_WC = 42 * MiB, WS_WA = 46 * MiB, WS_WMIX = 50 * MiB, WS_W1 = 58 * MiB, WS_W2 = 90 * MiB;
constexpr size_t WS_Z = 128 * MiB, WS_XN = 448 * MiB, WS_CONVY = 512 * MiB, WS_ATTO = 544 * MiB, WS_RN2 = 576 * MiB, WS_END = 577 * MiB;
constexpr int LDS_BYTES = att::LDS_BYTES + 65536 + 128;
static_assert(LDS_BYTES >= pg8::STAGE_BYTES, "LDS");
constexpr int NTHR = 512, NWAVES = 8;

#define LDS_WAIT() asm volatile("s_waitcnt lgkmcnt(0)" ::: "memory")
__device__ __forceinline__ unsigned f2bf(float f) { unsigned u = __builtin_bit_cast(unsigned, f); return (u + 0x7fffu + ((u >> 16) & 1u)) >> 16; }
__device__ __forceinline__ unsigned pk2(float lo, float hi) { return f2bf(lo) | (f2bf(hi) << 16); }
__device__ __forceinline__ float wave_sum(float v) {
#pragma unroll
    for (int o = 1; o < 64; o <<= 1) v += __shfl_xor(v, o);
    return v;
}
__device__ __forceinline__ void transpose_item(const float* W, int ldw, int split, int K, int N, bf16* WT, LAS float* scr, int item, int lane) {
    const int nblk = N / 32, kb = item / nblk, nb = item % nblk, k0 = 64 * kb, n0 = 32 * nb, c0 = n0 + (n0 >= split ? 8 : 0);
#pragma unroll 8
    for (int i = 0; i < 32; ++i) { const int kk = 2 * i + (lane >> 5); scr[kk * 33 + (lane & 31)] = W[(size_t)(k0 + kk) * ldw + c0 + (lane & 31)]; }
    LDS_WAIT(); asm volatile("" ::: "memory");
    const int c = lane & 7;
#pragma unroll
    for (int j = 0; j < 4; ++j) { const int n = (lane >> 3) + 8 * j; const LAS float* s = scr + (8 * c) * 33 + n;
        v4u o; o.x = pk2(s[0 * 33], s[1 * 33]); o.y = pk2(s[2 * 33], s[3 * 33]); o.z = pk2(s[4 * 33], s[5 * 33]); o.w = pk2(s[6 * 33], s[7 * 33]);
        *(v4u*)(WT + (size_t)(n0 + n) * K + k0 + 8 * c) = o; }
    LDS_WAIT(); asm volatile("" ::: "memory");
}
__device__ __forceinline__ void rms_load(f32x4 (&v)[8], const float* xrow, int lane) {
    const f32x4* xr = (const f32x4*)xrow + lane;
#pragma unroll
    for (int j = 0; j < 8; ++j) v[j] = xr[64 * j];
}
template <bool OUT_BF16, bool LOGF>
__device__ __forceinline__ void rms_row(const f32x4 (&v)[8], const float* g, bf16* orow, float* frow, int lane, const LAS float* gwf, float* logf_out, const float* bfp) {
    float s = 0.f;
#pragma unroll
    for (int j = 0; j < 8; ++j) { s += (v[j].x * v[j].x + v[j].y * v[j].y) + (v[j].z * v[j].z + v[j].w * v[j].w); }
    const float rstd = 1.0f / sqrtf(wave_sum(s) * (1.0f / DM) + EPS);
    if (LOGF) {
        float mine = 0.f;
#pragma nounroll
        for (int jj = 0; jj < 8; ++jj) { float t = 0.f;
#pragma unroll
            for (int j = 0; j < 8; ++j) { const f32x4 w = *(const LAS f32x4*)(gwf + jj * DM + 256 * j + 4 * lane); t += (v[j].x * w.x + v[j].y * w.y) + (v[j].z * w.z + v[j].w * w.w); }
            t = wave_sum(t) * rstd; mine = (lane == jj) ? t : mine; }
        if (lane < 8) { const float z = mine + bfp[lane]; logf_out[lane] = fminf(z, 0.f) - __logf(1.0f + __expf(-fabsf(z))); }
    }
#pragma unroll
    for (int j = 0; j < 8; ++j) { const f32x4 gg = ((const f32x4*)g)[64 * j + lane]; const f32x4 y = v[j] * rstd * gg;
        if (OUT_BF16) { v2u o; o.x = pk2(y.x, y.y); o.y = pk2(y.z, y.w); ((v2u*)orow)[64 * j + lane] = o; }
        else ((f32x4*)frow)[64 * j + lane] = y; }
}
__device__ __forceinline__ void cumsum_head(const float* logf, float* cs, int h, LAS float* sm, int tid) {
    const int lane = tid & 63, wave = tid >> 6;
    float v[32]; const float* p = logf + (size_t)(32 * tid) * NH + h; float s = 0.f;
#pragma unroll
    for (int i = 0; i < 32; ++i) { v[i] = p[i * NH]; }
#pragma unroll
    for (int i = 0; i < 32; ++i) { s += v[i]; }
    float inc = s;
#pragma unroll
    for (int o = 1; o < 64; o <<= 1) { const float n = __shfl_up(inc, o); if (lane >= o) inc += n; }
    if (lane == 63) sm[wave] = inc;
    __syncthreads();
    float wp = 0.f;
#pragma unroll
    for (int w = 0; w < 8; ++w) wp += (w < wave) ? sm[w] : 0.f;
    float run = wp + inc - s;
    float* o = cs + (size_t)h * S + 32 * tid;
#pragma unroll
    for (int i = 0; i < 32; i += 4) { f32x4 q; run += v[i]; q.x = run * SQRT_HD; run += v[i + 1]; q.y = run * SQRT_HD; run += v[i + 2]; q.z = run * SQRT_HD; run += v[i + 3]; q.w = run * SQRT_HD; *(f32x4*)(o + i) = q; }
    __syncthreads();
}
__device__ __forceinline__ void unpack8f(const v4u w, float (&f)[8]) {
    f[0] = __uint_as_float(w.x << 16); f[1] = __uint_as_float(w.x & 0xffff0000u); f[2] = __uint_as_float(w.y << 16); f[3] = __uint_as_float(w.y & 0xffff0000u);
    f[4] = __uint_as_float(w.z << 16); f[5] = __uint_as_float(w.z & 0xffff0000u); f[6] = __uint_as_float(w.w << 16); f[7] = __uint_as_float(w.w & 0xffff0000u);
}
__device__ __forceinline__ void conv_item(const bf16* z, const float* cw, bf16* convy, int item, int lane) {
    const int t0 = (item >> 1) * 16, c0 = (item & 1) * 512 + lane * 8;
    float w0[8], w1[8], w2[8], p2[8], p1[8];
#pragma unroll
    for (int e = 0; e < 8; ++e) { w0[e] = cw[c0 + e]; w1[e] = cw[CWD + c0 + e]; w2[e] = cw[2 * CWD + c0 + e]; p2[e] = 0.f; p1[e] = 0.f; }
    if (t0 >= 2) {
        float a[8], b[8];
        unpack8f(*(const v4u*)(z + (size_t)(t0 - 2) * NIN + CWD + c0), a); unpack8f(*(const v4u*)(z + (size_t)(t0 - 2) * NIN + 2 * CWD + c0), b);
#pragma unroll
        for (int e = 0; e < 8; ++e) p2[e] = a[e] * b[e];
        unpack8f(*(const v4u*)(z + (size_t)(t0 - 1) * NIN + CWD + c0), a); unpack8f(*(const v4u*)(z + (size_t)(t0 - 1) * NIN + 2 * CWD + c0), b);
#pragma unroll
        for (int e = 0; e < 8; ++e) p1[e] = a[e] * b[e];
    }
#pragma nounroll
    for (int rb = 0; rb < 16; rb += 8) {
        v4u xd[8], xa[8], xb[8];
#pragma unroll
        for (int q = 0; q < 8; ++q) { const bf16* zr = z + (size_t)(t0 + rb + q) * NIN + c0; xd[q] = *(const v4u*)(zr); xa[q] = *(const v4u*)(zr + CWD); xb[q] = *(const v4u*)(zr + 2 * CWD); }
#pragma unroll
        for (int q = 0; q < 8; ++q) { float a[8], b[8], d[8], y[8];
            unpack8f(xd[q], d); unpack8f(xa[q], a); unpack8f(xb[q], b);
#pragma unroll
            for (int e = 0; e < 8; ++e) { const float pc = a[e] * b[e]; y[e] = d[e] * (w0[e] * p2[e] + w1[e] * p1[e] + w2[e] * pc); p2[e] = p1[e]; p1[e] = pc; }
            v4u o; o.x = pk2(y[0], y[1]); o.y = pk2(y[2], y[3]); o.z = pk2(y[4], y[5]); o.w = pk2(y[6], y[7]);
            *(v4u*)(convy + (size_t)(t0 + rb + q) * CWD + c0) = o; }
    }
}

#define XB_TMO      128
#define XB_XCNT(j)  (256  + 64 * (j))
#define XB_XSUB(j)  (1280 + 64 * (j))
#define XB_XGEN(j)  (2304 + 64 * (j))
#define XB_TOP      3328
#define XB_TOPGEN   3392
#define XCD_BAR_WORDS 3456
#define XB_SPIN_CAP (1u << 18)

__device__ __forceinline__ unsigned xb_ld(unsigned* p)              { return __hip_atomic_load(p, __ATOMIC_RELAXED, __HIP_MEMORY_SCOPE_AGENT); }
__device__ __forceinline__ unsigned xb_add(unsigned* p, unsigned v) { return __hip_atomic_fetch_add(p, v, __ATOMIC_RELAXED, __HIP_MEMORY_SCOPE_AGENT); }
__device__ __forceinline__ unsigned xb_xcc_id() { return (unsigned)__builtin_amdgcn_s_getreg((3 << 11) | 20) & 0xFu; }
#define XB_SPIN(cond, bar) do { unsigned _sp = 0; while (cond) { __builtin_amdgcn_s_sleep(1); \
    if ((++_sp & 255u) == 0u) { if (xb_ld(&(bar)[XB_TMO])) break; if (_sp > XB_SPIN_CAP) { atomicAdd(&(bar)[XB_TMO], 1u); break; } } } } while (0)

struct XcdBarrier {
    unsigned* bar; unsigned x;
    volatile LAS unsigned* st;
};

__device__ __forceinline__ XcdBarrier xcd_barrier_post(unsigned* bar, volatile LAS unsigned* st) {
    XcdBarrier b; b.bar = bar; b.x = xb_xcc_id(); b.st = st;
    if (threadIdx.x == 0) (void)xb_add(&bar[XB_XCNT(b.x)], 1u);
    return b;
}
__device__ __forceinline__ void xcd_barrier_complete(unsigned* bar, unsigned x, unsigned& nloc, unsigned& nx) {
    const unsigned G = gridDim.x * gridDim.y * gridDim.z;
    unsigned sum, cnt, mine, sp = 0u;
    for (;;) {
        sum = 0u; cnt = 0u; mine = 0u;
#pragma unroll
        for (unsigned j = 0; j < 16; ++j) { const unsigned c = xb_ld(&bar[XB_XCNT(j)]); sum += c; cnt += (c > 0u) ? 1u : 0u; mine = (j == x) ? c : mine; }
        if (sum == G) break;
        __builtin_amdgcn_s_sleep(1);
        if ((++sp & 255u) == 0u) { if (xb_ld(&bar[XB_TMO])) break; if (sp > XB_SPIN_CAP) { atomicAdd(&bar[XB_TMO], 1u); break; } }
    }
    nloc = mine > 0u ? mine : 1u; nx = cnt > 0u ? cnt : 1u;
}

__device__ __forceinline__ void xcd_barrier(const XcdBarrier& b) {
    asm volatile("s_waitcnt vmcnt(0)" ::: "memory");
    __syncthreads();
    if (threadIdx.x == 0) {
        unsigned* bar = b.bar;
        __builtin_amdgcn_s_waitcnt(0);
        unsigned nloc = b.st[0], nx = b.st[1];
        if (nloc == 0u) { xcd_barrier_complete(bar, b.x, nloc, nx); b.st[0] = nloc; b.st[1] = nx; }
        const unsigned old = xb_add(&bar[XB_XSUB(b.x)], 1u);
        const unsigned gen = old / nloc;
        if (old + 1u == (gen + 1u) * nloc) {
            __builtin_amdgcn_fence(__ATOMIC_RELEASE, "agent");
            asm volatile("s_waitcnt vmcnt(0)" ::: "memory");
            const unsigned og = xb_add(&bar[XB_TOP], 1u);
            const unsigned tg = og / nx;
            if (og + 1u == (tg + 1u) * nx) xb_add(&bar[XB_TOPGEN], 1u);
            else XB_SPIN(xb_ld(&bar[XB_TOPGEN]) == tg, bar);
            __builtin_amdgcn_fence(__ATOMIC_ACQUIRE, "agent");
            xb_add(&bar[XB_XGEN(b.x)], 1u);
            asm volatile("s_waitcnt vmcnt(0)" ::: "memory");
        } else {
            XB_SPIN(xb_ld(&bar[XB_XGEN(b.x)]) == gen, bar);
            __builtin_amdgcn_fence(__ATOMIC_ACQUIRE, "agent");
            asm volatile("s_waitcnt vmcnt(0)" ::: "memory");
        }
    }
    __syncthreads();
}

__device__ __forceinline__ int compute_jlo(const float* csh, const float* rq, const float* rk, int qb_in, int* sm, int tid0) {
    int t = tid0; asm volatile("" : "+v"(t)); int qb = qb_in; asm volatile("" : "+s"(qb));
    if (t == 0) { sm[0] = 4 * qb; sm[1] = 0; sm[3] = 0; }
    float kn = 0.f, qn = (t < 256) ? rq[qb * 256 + t] : 0.f;
    const int nk = (qb + 1) * 256;
#pragma unroll
    for (int j = 0; j < 8; ++j) { if (j * 2048 < nk) { const f32x4 v = ((const f32x4*)rk)[j * NTHR + t]; kn = fmaxf(kn, fmaxf(fmaxf(v.x, v.y), fmaxf(v.z, v.w))); } }
#define JLO_SW(o) do { kn = fmaxf(kn, __int_as_float(__builtin_amdgcn_ds_swizzle(__float_as_int(kn), 0x1f | ((o) << 10)))); qn = fmaxf(qn, __int_as_float(__builtin_amdgcn_ds_swizzle(__float_as_int(qn), 0x1f | ((o) << 10)))); } while (0)
    JLO_SW(1); JLO_SW(2); JLO_SW(4); JLO_SW(8); JLO_SW(16);
#undef JLO_SW
    __syncthreads();
    if ((t & 31) == 0) { atomicMax((unsigned*)&sm[1], __float_as_uint(kn)); atomicMax((unsigned*)&sm[3], __float_as_uint(qn)); }
    __syncthreads();
    const float K2 = __uint_as_float((unsigned)sm[1]), Q2 = __uint_as_float((unsigned)sm[3]);
    const float qk2 = 2.0f * sqrtf(Q2 * K2) * 1.01f, c0 = csh[qb * 256];
    if (t < 4 * qb) { const float ce = csh[64 * t + 63]; if (!((qk2 + c0 - ce) <= -110.0f * SQRT_HD)) atomicMin(&sm[0], t); }
    __syncthreads();
    const int j = sm[0];
    __syncthreads();
    return j;
}

struct Args { const float* in[13]; float* out; unsigned char* ws; };

__global__ void __launch_bounds__(NTHR, 2) fwd_megakernel(Args args) {
    extern __shared__ __attribute__((aligned(16))) unsigned char lds[];
    cg::grid_group grid = cg::this_grid();
    LAS unsigned char* L = (LAS unsigned char*)lds;
    const int tid0 = threadIdx.x, wave = __builtin_amdgcn_readfirstlane(tid0 >> 6);
#define LAUNDER_TID() int tid = tid0; asm volatile("" : "+v"(tid)); const int lane = tid & 63
    const int G = gridDim.x, bid = blockIdx.x, gw = bid * NWAVES + wave, NGW = G * NWAVES;
    unsigned char* ws = args.ws;
    float* rn2 = (float*)(ws + WS_RN2);
    float* logf = (float*)(ws + WS_LOGF); float* cs = (float*)(ws + WS_CS);
    bf16* Win_t = (bf16*)(ws + WS_WIN); bf16* Wc_t = (bf16*)(ws + WS_WC); bf16* Wa_t = (bf16*)(ws + WS_WA); bf16* Wmix_t = (bf16*)(ws + WS_WMIX);
    bf16* W1_t = (bf16*)(ws + WS_W1); bf16* W2_t = (bf16*)(ws + WS_W2);
    bf16* Z = (bf16*)(ws + WS_Z); bf16* XN = (bf16*)(ws + WS_XN); bf16* CONVY = (bf16*)(ws + WS_CONVY); bf16* ATTO = (bf16*)(ws + WS_ATTO);
    bf16* XG = (bf16*)(ws + WS_Z + 256 * MiB);
    float* rowss = (float*)(ws + WS_RSS);
    float* xres = args.out;
    volatile LAS unsigned* bst = (volatile LAS unsigned*)(L + att::LDS_BYTES + 65536 + 64);
    if (tid0 < 2) bst[tid0] = 0u;
    __syncthreads();
    const XcdBarrier xbar = xcd_barrier_post((unsigned*)(ws + WS_BAR), bst);
#ifdef EXTRA_SYNCS
#define GRID_SYNC() do { xcd_barrier(xbar); } while (0)
#else
#define GRID_SYNC() do { xcd_barrier(xbar); } while (0)
#endif

#pragma nounroll
    for (int l = 0; l < 2; ++l) {
        const float* xin = (l == 0) ? args.in[0] : (const float*)xres;
        const float* g_mix = args.in[1] + (size_t)l * DM; const float* w_in = args.in[2] + (size_t)l * DM * NINSRC;
        const float* b_f = args.in[3] + l * NH; const float* b_gate = args.in[4] + (size_t)l * 2 * DM; const float* conv_w = args.in[5] + (size_t)l * 3 * CWD;
        const float* w_c = args.in[6] + (size_t)l * CWD * DM; const float* w_a = args.in[7] + (size_t)l * CWD * DM; const float* w_mix = args.in[8] + (size_t)l * DM * DM;
        const float* g_mlp = args.in[9] + (size_t)l * DM; const float* w1 = args.in[10] + (size_t)l * DM * FF; const float* w2 = args.in[11] + (size_t)l * FF * DM;

#ifndef REP_P0
#define REP_P0 1
#endif
#pragma nounroll
        for (int rep_ = 0; rep_ < REP_P0; ++rep_) {
            if (rep_) __syncthreads();
            LAUNDER_TID();
            for (int b = bid; b < (16 * S) / (2 * NTHR); b += G) { rn2[b * 2 * NTHR + tid] = 0.f; rn2[b * 2 * NTHR + NTHR + tid] = 0.f; }
            if (bid == 1 % G) { for (int i = tid; i < S; i += NTHR) rowss[i] = 0.f; }
            LAS float* scr = (LAS float*)(L + wave * 16384);
            constexpr int I_IN = (DM / 64) * (NIN / 32), I_C = (CWD / 64) * (DM / 32), I_MIX = (DM / 64) * (DM / 32), I_1 = (DM / 64) * (FF / 32), I_2 = (FF / 64) * (DM / 32);
            constexpr int NITEMS = I_IN + 2 * I_C + I_MIX + I_1 + I_2;
            for (int it = gw; it < NITEMS; it += NGW) {
                int r = it;
                if (r < I_IN) { transpose_item(w_in, NINSRC, FCOL, DM, NIN, Win_t, scr, r, lane); continue; } r -= I_IN;
                if (r < I_C) { transpose_item(w_c, DM, 1 << 30, CWD, DM, Wc_t, scr, r, lane); continue; } r -= I_C;
                if (r < I_C) { transpose_item(w_a, DM, 1 << 30, CWD, DM, Wa_t, scr, r, lane); continue; } r -= I_C;
                if (r < I_MIX) { transpose_item(w_mix, DM, 1 << 30, DM, DM, Wmix_t, scr, r, lane); continue; } r -= I_MIX;
                if (r < I_1) { transpose_item(w1, FF, 1 << 30, DM, FF, W1_t, scr, r, lane); continue; } r -= I_1;
                transpose_item(w2, DM, 1 << 30, FF, DM, W2_t, scr, r, lane);
            }
            __syncthreads();
            LAS float* gwf = (LAS float*)L;
#pragma unroll
            for (int i_ = 0; i_ < DM / NTHR; ++i_) { const int k = tid + i_ * NTHR; const float* wp = w_in + (size_t)k * NINSRC + FCOL; const f32x4 a = *(const f32x4*)wp, b = *(const f32x4*)(wp + 4); const float gk = g_mix[k];
                gwf[0 * DM + k] = gk * a.x; gwf[1 * DM + k] = gk * a.y; gwf[2 * DM + k] = gk * a.z; gwf[3 * DM + k] = gk * a.w;
                gwf[4 * DM + k] = gk * b.x; gwf[5 * DM + k] = gk * b.y; gwf[6 * DM + k] = gk * b.z; gwf[7 * DM + k] = gk * b.w; }
            __syncthreads();
            {   f32x4 rv[8], rn[8]; rms_load(rv, xin + (size_t)gw * DM, lane);
                for (int m = gw; m < S; m += NGW) {
                    const int mn = (m + NGW < S) ? m + NGW : m; rms_load(rn, xin + (size_t)mn * DM, lane);
                    rms_row<true, true>(rv, g_mix, XN + (size_t)m * DM, nullptr, lane, gwf, logf + (size_t)m * NH, b_f);
#pragma unroll
                    for (int j = 0; j < 8; ++j) rv[j] = rn[j]; } }
        }
        if (l == 0) { __syncthreads(); grid.sync(); } else GRID_SYNC();

        {
            { LAUNDER_TID(); if (bid < NH) cumsum_head(logf, cs, bid, (LAS float*)L, tid); }
            pg8::Gemm g{XN, Win_t, S, NIN, DM, DM}; pg8::StaticOrder So; So.init(S, NIN, G, bid);
            pg8::Epi<pg8::EP_INPROJ> E{Z, NIN, nullptr, 0, nullptr, (3 * CWD) / 256  , nullptr, nullptr, b_gate, FCOL / 256, rn2};
#ifndef REP_P1
#define REP_P1 1
#endif
#pragma nounroll
            for (int rep_ = 0; rep_ < REP_P1; ++rep_)
            pg8::gemm_phase<pg8::Epi<pg8::EP_INPROJ>, pg8::StaticOrder, true, true>(L, g, So, E);
        }
        GRID_SYNC();

#ifndef REP_P2
#define REP_P2 1
#endif
#pragma nounroll
        for (int rep_ = 0; rep_ < REP_P2; ++rep_) {
            if (rep_) GRID_SYNC();
            LAUNDER_TID();
            using abf = att::bf16; typedef att::BlockRef<abf, abf> BR;
            char* al = (char*)lds; float* csl = (float*)((char*)lds + att::LDS_BYTES);
            const abf* Qb = (const abf*)Z + 3 * CWD; const abf* Kb = (const abf*)Z + 4 * CWD;
            constexpr int NQB = S / att::QB, NITEM = NH * (NQB / 2);
            unsigned ord = 0u;
            {   float ce[NH];
#pragma unroll
                for (int h = 0; h < NH; ++h) ce[h] = cs[(size_t)h * S + S - 1];
#pragma unroll
                for (int hh = 0; hh < NH; ++hh) { int rr = 0;
#pragma unroll
                    for (int g2 = 0; g2 < NH; ++g2) rr += (ce[g2] > ce[hh] || (ce[g2] == ce[hh] && g2 < hh)) ? 1 : 0;
                    ord |= (unsigned)hh << (4 * rr); }
                ord = __builtin_amdgcn_readfirstlane(ord); }
            {
                unsigned* actr = (unsigned*)(ws + WS_CTR) + 64 * l + 16;
                int* smi2 = (int*)((char*)lds + att::LDS_BYTES + 65536);
                int Ls = (G % 8 == 0) ? (bid % 8) * (G / 8) + bid / 8 : bid; bool dyn = true;
#define MK_REF(r, Lx, ps) do { const int i_ = (Lx), rk_ = i_ >> 6, qb_ = (NQB - 1) - (i_ & (NQB - 1)), h_ = (int)((ord >> (4 * rk_)) & 7u); \
                    (r).Q = Qb + h_ * 128 + (size_t)qb_ * att::QB * NIN; (r).O = (abf*)ATTO + h_ * 128 + (size_t)qb_ * att::QB * CWD; (r).K = Kb + h_ * 128; (r).P0 = qb_ * att::QB; (r).C = cs + (size_t)h_ * S; (r).JLO = compute_jlo((r).C, rn2 + (size_t)h_ * S, rn2 + (size_t)(NH + h_) * S, qb_, (int*)((char*)lds + att::LDS_BYTES + 65536), tid0); } while (0)
                att::Seam<abf> Sm;
                for (;;) {
                    int pos;
                    if (!dyn) { pos = Ls; if (pos >= NITEM) { dyn = true; continue; } Ls += G; }
                    else { int t4 = tid0; asm volatile("" : "+v"(t4)); if (t4 == 0) smi2[2] = (int)atomicAdd(actr, 1u);
                        __syncthreads(); pos = __builtin_amdgcn_readfirstlane(smi2[2]); __syncthreads();
                        if (pos >= 2 * NITEM) break; }
                    BR cur; MK_REF(cur, pos, 0);
                    att::causal_swa_prime<abf, abf>(cur, S, al, Sm);
                    { const int n4 = (cur.P0 + att::QB) / 4; int t2 = tid0; asm volatile("" : "+v"(t2)); for (int i = cur.JLO * 16 + t2; i < n4; i += NTHR) ((f32x4*)csl)[i] = ((const f32x4*)cur.C)[i]; }
                    __syncthreads();
                    att::causal_swa_block<abf, abf>(cur, cur, S, S, al, Sm, csl);
                }
#undef MK_REF
            }
            {   unsigned* ctr = (unsigned*)(ws + WS_CTR) + 64 * l; int* smi = (int*)((char*)lds + att::LDS_BYTES + 65536);
                int t3 = tid0; asm volatile("" : "+v"(t3)); const int lane3 = t3 & 63;
                for (;;) {
                    if (t3 == 0) smi[2] = (int)atomicAdd(ctr, 8u);
                    __syncthreads();
                    const int base = __builtin_amdgcn_readfirstlane(smi[2]);
                    __syncthreads();
                    if (base >= (S / 16) * 2) break;
                    conv_item(Z, conv_w, CONVY, base + wave, lane3);
                }
            }
        }
        GRID_SYNC();

        {
            pg8::Gemm g{CONVY, Wc_t, S, DM, CWD, CWD}; pg8::StaticOrder So; So.init(S, DM, G, bid);
            pg8::Epi<pg8::EP_T1> E{Z, NIN, Z + FCOL, NIN, nullptr, 0, nullptr, nullptr, nullptr, 0, nullptr};
            pg8::gemm_phase<pg8::Epi<pg8::EP_T1>, pg8::StaticOrder, true, true>(L, g, So, E);
        }
        {
            pg8::Gemm g{ATTO, Wa_t, S, DM, CWD, CWD}; pg8::StaticOrder So; So.init(S, DM, G, bid);
            pg8::Epi<pg8::EP_MERGE> E{XN, DM, Z + FCOL + DM, NIN, Z, NIN, nullptr, nullptr, nullptr, 0, nullptr};
            pg8::gemm_phase<pg8::Epi<pg8::EP_MERGE>, pg8::StaticOrder, true, true>(L, g, So, E);
        }
        GRID_SYNC();

        {
            pg8::Gemm g{XN, Wmix_t, S, DM, DM, DM}; pg8::StaticOrder So; So.init(S, DM, G, bid);
            pg8::Epi<pg8::EP_RESID_N> E{XG, DM, nullptr, 0, nullptr, 0, xin, xres, g_mlp, 0, rowss};
            pg8::gemm_phase<pg8::Epi<pg8::EP_RESID_N>, pg8::StaticOrder, true, true>(L, g, So, E);
        }
        GRID_SYNC();


        {
            pg8::Gemm g{XG, W1_t, S, FF, DM, DM}; pg8::StaticOrder So; So.init(S, FF, G, bid);
            pg8::Epi<pg8::EP_RELU2> E{Z, FF, nullptr, 0, nullptr, 0, nullptr, nullptr, nullptr, 0, rowss};
#ifndef REP_P7
#define REP_P7 1
#endif
#pragma nounroll
            for (int rep_ = 0; rep_ < REP_P7; ++rep_)
            pg8::gemm_phase<pg8::Epi<pg8::EP_RELU2>, pg8::StaticOrder, true, true>(L, g, So, E);
        }
        GRID_SYNC();

        {
            pg8::Gemm g{Z, W2_t, S, DM, FF, FF}; pg8::StaticOrder So; So.init(S, DM, G, bid);
            pg8::Epi<pg8::EP_RESID> E{nullptr, 0, nullptr, 0, nullptr, 0, xres, xres, nullptr, 0, nullptr};
            pg8::gemm_phase<pg8::Epi<pg8::EP_RESID>, pg8::StaticOrder, true, true>(L, g, So, E);
        }
        GRID_SYNC();
    }
#ifdef EXTRA_SYNCS
#pragma nounroll
    for (int i = 0; i < EXTRA_SYNCS; ++i) GRID_SYNC();
#endif
    {   LAUNDER_TID(); f32x4 rv[8], rn[8]; rms_load(rv, xres + (size_t)gw * DM, lane);
        for (int m = gw; m < S; m += NGW) {
            const int mn = (m + NGW < S) ? m + NGW : m; rms_load(rn, xres + (size_t)mn * DM, lane);
            rms_row<false, false>(rv, args.in[12], nullptr, xres + (size_t)m * DM, lane, nullptr, nullptr, nullptr);
#pragma unroll
            for (int j = 0; j < 8; ++j) rv[j] = rn[j]; } }
}
}

extern "C" void kernel_launch(void* const* d_in, const int* in_sizes, int n_in, void* d_out, int out_size, void* d_ws, size_t ws_size, hipStream_t stream) {
    static int grid = 0;
    if (grid == 0) {
        if (n_in != 13 || out_size != mk::S * mk::DM || ws_size < mk::WS_END) { fprintf(stderr, "kernel_launch: unexpected shapes (n_in %d out %d ws %zu)\n", n_in, out_size, ws_size); grid = -1; return; }
        int dev = 0, cus = 0, per_cu = 0;
        (void)hipGetDevice(&dev); (void)hipDeviceGetAttribute(&cus, hipDeviceAttributeMultiprocessorCount, dev);
        if (hipFuncSetAttribute((const void*)mk::fwd_megakernel, hipFuncAttributeMaxDynamicSharedMemorySize, mk::LDS_BYTES) != hipSuccess) { fprintf(stderr, "kernel_launch: hipFuncSetAttribute failed\n"); grid = -1; return; }
        if (hipOccupancyMaxActiveBlocksPerMultiprocessor(&per_cu, (const void*)mk::fwd_megakernel, mk::NTHR, mk::LDS_BYTES) != hipSuccess || per_cu < 1) { fprintf(stderr, "kernel_launch: occupancy query says %d\n", per_cu); per_cu = 1; }
        (void)hipGetLastError();
        grid = cus * per_cu;
    }
    if (grid < 0) return;
    if (hipMemsetAsync(d_ws, 0, mk::CTL_ZERO_BYTES, stream) != hipSuccess) { fprintf(stderr, "kernel_launch: hipMemsetAsync failed\n"); return; }
    mk::Args a{};
    for (int i = 0; i < 13; ++i) a.in[i] = (const float*)d_in[i];
    a.out = (float*)d_out; a.ws = (unsigned char*)d_ws;
    void* kargs[] = {&a};
    hipError_t e = hipLaunchCooperativeKernel((const void*)mk::fwd_megakernel, dim3(grid), dim3(mk::NTHR), kargs, mk::LDS_BYTES, stream);
    if (e != hipSuccess) fprintf(stderr, "kernel_launch: cooperative launch failed: %s (grid %d)\n", hipGetErrorString(e), grid);
}
```

```cpp
#include <hip/hip_runtime.h>
#include <hip/hip_cooperative_groups.h>
#include <hip/hip_bf16.h>
#include <cstdio>
#include <cstdint>
#include <cmath>
namespace cg = cooperative_groups;

namespace pg8 {
#define PG8_LAS __attribute__((address_space(3)))
typedef unsigned short bf16_t;
typedef short bf16x8 __attribute__((ext_vector_type(8)));
typedef float f32x4 __attribute__((ext_vector_type(4)));
typedef unsigned u32x4 __attribute__((ext_vector_type(4)));
constexpr int BM = 256, BK = 64, HALF = 128, HTB = HALF * BK * 2  , STAGE_BYTES = 8 * HTB, NXCD = 8, WGM = 4;

__host__ __device__ __forceinline__ int lds_byte(int r, int c) { const int st = (r >> 4) * 2 + (c >> 5), rr = r & 15, cc = c & 31, ob = rr * 64 + cc * 2; return st * 1024 + (ob ^ (((ob >> 9) & 1) << 5)); }
__host__ __device__ __forceinline__ void stage_rc(int b, int& R, int& C) { const int st = b / 1024, sb = b % 1024, swz = sb ^ (((sb >> 9) & 1) << 5); R = (st >> 1) * 16 + swz / 64; C = (st & 1) * 32 + (swz % 64) / 2; }
__host__ __device__ __forceinline__ int perm32(int rho) { const int n = rho >> 4, i = rho & 15; return 8 * (i >> 2) + 4 * n + (i & 3); }

struct Unit { int pm, pn; };
struct Gemm { const bf16_t* A; const bf16_t* Bt; int M, N, K, lda; };

struct StaticOrder {
    int nM, nN, nwg, G, c;
    __host__ __device__ void init(int M, int N, int G_, int c_) { nM = M / BM; nN = N / BM; nwg = nM * nN; G = G_; c = c_; }
    __host__ __device__ bool next(int i, Unit& u) const {
        const long L = (long)i * G + c; if (L >= nwg) return false;
        int wgid = (int)L; { const int q = nwg / NXCD, r = nwg % NXCD, xcd = wgid % NXCD, off = wgid / NXCD; wgid = (xcd < r ? xcd * (q + 1) : r * (q + 1) + (xcd - r) * q) + off; }
        const int nig = WGM * nN, gid = wgid / nig, fm = gid * WGM, gsz = (nM - fm) < WGM ? (nM - fm) : WGM;
        u.pm = fm + ((wgid % nig) % gsz); u.pn = (wgid % nig) / gsz; return true;
    }
    __device__ __forceinline__ void a_ready(const Unit&) const {}
    __device__ __forceinline__ void done(const Unit&) const {}
};


__device__ __forceinline__ unsigned cvt_pk_bf16(float lo, float hi) { unsigned r; asm volatile("v_cvt_pk_bf16_f32 %0, %1, %2" : "=v"(r) : "v"(lo), "v"(hi)); return r; }
__device__ __forceinline__ void unpack8(const u32x4 w, f32x4& a, f32x4& b) {
    a[0] = __uint_as_float(w.x << 16); a[1] = __uint_as_float(w.x & 0xffff0000u); a[2] = __uint_as_float(w.y << 16); a[3] = __uint_as_float(w.y & 0xffff0000u);
    b[0] = __uint_as_float(w.z << 16); b[1] = __uint_as_float(w.z & 0xffff0000u); b[2] = __uint_as_float(w.w << 16); b[3] = __uint_as_float(w.w & 0xffff0000u);
}
__device__ __forceinline__ float sum_fq(float v) {
    v += __int_as_float(__builtin_amdgcn_ds_swizzle(__float_as_int(v), 0x1f | (16 << 10)));
    const auto rr = __builtin_amdgcn_permlane32_swap(__float_as_uint(v), __float_as_uint(v), false, false);
    return __uint_as_float(rr[0]) + __uint_as_float(rr[1]);
}
__device__ __forceinline__ f32x4 sigmoid4(f32x4 v) { f32x4 o;
#pragma unroll
    for (int i = 0; i < 4; ++i) o[i] = __builtin_amdgcn_rcpf(1.0f + __expf(-v[i]));
    return o; }
enum { EP_INPROJ = 0, EP_T1 = 1, EP_MERGE = 2, EP_RESID = 3, EP_RELU2 = 4, EP_RESID_N = 5 };
template <int MODE> struct Epi {
    static constexpr bool PERM = true, AFTER_DRAIN = false;
    bf16_t* O; int ldc; const bf16_t* Gt; int ldg; const bf16_t* T; int ldt; const float* X; float* XO; const float* bias; int gate_tile0; float* RS;
    __device__ __forceinline__ void operator()(const f32x4 (&acc)[2][2][4][2], const Unit& u, int wr, int wc, int fr, int fq) const {
        run<false>(acc, u, wr, wc, fr, fq);
    }
    template <bool GATE> __device__ __forceinline__ void run(const f32x4 (&acc)[2][2][4][2], const Unit& u, int wr, int wc, int fr, int fq) const {
        const int row0 = u.pm * BM + wr * 64 + fr, col0 = u.pn * BM + wc * 32 + 8 * fq;
        const bool gate = (MODE == EP_INPROJ) && (u.pn >= gate_tile0);
        f32x4 bv[2][2];
#pragma unroll
        for (int bj = 0; bj < 2; ++bj)
#pragma unroll
            for (int n = 0; n < 2; ++n) { bv[bj][n] = (f32x4){0.f, 0.f, 0.f, 0.f}; if (MODE == EP_INPROJ) bv[bj][n] = *(const f32x4*)(bias + (gate ? col0 - gate_tile0 * BM : 0) + bj * HALF + 4 * n); }
        if (MODE == EP_INPROJ) asm volatile("" : "+v"(bv[0][0]), "+v"(bv[0][1]), "+v"(bv[1][0]), "+v"(bv[1][1]));
        if (MODE == EP_RESID_N) {
#pragma unroll
            for (int bj = 0; bj < 2; ++bj)
#pragma unroll
                for (int n = 0; n < 2; ++n) bv[bj][n] = *(const f32x4*)(bias + col0 + bj * HALF + 4 * n);
        }
        float rsc[2][4];
#pragma unroll
        for (int ai = 0; ai < 2; ++ai)
#pragma unroll
            for (int m = 0; m < 4; ++m) rsc[ai][m] = (MODE == EP_RELU2) ? __builtin_amdgcn_rcpf(RS[row0 + ai * HALF + m * 16] * (1.0f / 2048.0f) + 1e-6f) : 1.0f;
#pragma unroll
        for (int ai = 0; ai < 2; ++ai)
#pragma unroll
            for (int m = 0; m < 4; ++m) { const size_t r = (size_t)(row0 + ai * HALF + m * 16); float ss = 0.f;
#pragma unroll
                for (int bj = 0; bj < 2; ++bj) { const int c = col0 + bj * HALF; f32x4 v0 = acc[ai][bj][m][0], v1 = acc[ai][bj][m][1];
                    if (MODE == EP_INPROJ) { if (gate) { v0 = sigmoid4(v0 + bv[bj][0]); v1 = sigmoid4(v1 + bv[bj][1]); } }
                    if (MODE == EP_T1 || MODE == EP_MERGE) { f32x4 g0, g1; unpack8(*(const u32x4*)(Gt + r * ldg + c), g0, g1); v0 = v0 * g0; v1 = v1 * g1; }
                    if (MODE == EP_MERGE) { f32x4 t0, t1; unpack8(*(const u32x4*)(T + r * ldt + c), t0, t1); v0 = v0 + t0; v1 = v1 + t1; }
                    if (MODE == EP_RELU2) {
#pragma unroll
                        for (int i = 0; i < 4; ++i) { const float a = fmaxf(v0[i], 0.f), b = fmaxf(v1[i], 0.f); v0[i] = a * a * rsc[ai][m]; v1[i] = b * b * rsc[ai][m]; } }
                    if (MODE == EP_RESID_N) { const float* xp = X + r * 2048 + c; float* op = XO + r * 2048 + c;
                        const f32x4 y0 = *(const f32x4*)xp + v0, y1 = *(const f32x4*)(xp + 4) + v1; *(f32x4*)op = y0; *(f32x4*)(op + 4) = y1;
                        ss += (y0[0] * y0[0] + y0[1] * y0[1]) + (y0[2] * y0[2] + y0[3] * y0[3]) + (y1[0] * y1[0] + y1[1] * y1[1]) + (y1[2] * y1[2] + y1[3] * y1[3]);
                        v0 = y0 * bv[bj][0]; v1 = y1 * bv[bj][1]; }
                    if (MODE == EP_RESID) { const float* xp = X + r * 2048 + c; float* op = XO + r * 2048 + c;
                        const f32x4 x0 = *(const f32x4*)xp, x1 = *(const f32x4*)(xp + 4); *(f32x4*)op = x0 + v0; *(f32x4*)(op + 4) = x1 + v1; }
                    else { u32x4 w; w.x = cvt_pk_bf16(v0[0], v0[1]); w.y = cvt_pk_bf16(v0[2], v0[3]); w.z = cvt_pk_bf16(v1[0], v1[1]); w.w = cvt_pk_bf16(v1[2], v1[3]);
                        *(u32x4*)(O + r * ldc + c) = w; } }
                if (MODE == EP_INPROJ) { if (u.pn >= ldt && u.pn < ldt + 8) {
#pragma unroll
                    for (int bj = 0; bj < 2; ++bj) { const f32x4 a = acc[ai][bj][m][0], b = acc[ai][bj][m][1];
                        float s2 = (a[0] * a[0] + a[1] * a[1]) + (a[2] * a[2] + a[3] * a[3]) + (b[0] * b[0] + b[1] * b[1]) + (b[2] * b[2] + b[3] * b[3]);
                        s2 = sum_fq(s2);
                        if (fq == 0) atomicAdd(RS + (size_t)((u.pn - ldt) * 2 + bj) * 16384 + r, s2); } } }
                if (MODE == EP_RESID_N) { ss = sum_fq(ss); if (fq == 0) atomicAdd(RS + r, ss); }
                if (MODE == EP_T1 || MODE == EP_MERGE || MODE == EP_RESID || MODE == EP_RESID_N) asm volatile("" ::: "memory"); }
    }
};

template <class Epi, class Sched, bool ALIGN_EPI = false, bool SP2 = false>
__device__ __forceinline__ void gemm_phase(PG8_LAS unsigned char* lds, const Gemm g, const Sched& S, const Epi& E) {
    int tid_ = threadIdx.x; asm volatile("" : "+v"(tid_));
    const int tid = tid_, wid = __builtin_amdgcn_readfirstlane(tid >> 6), lane = tid & 63, wr = wid >> 2, wc = wid & 3, fr = lane & 15, fq = lane >> 4;
    const int K = g.K, nt = K / BK, lda = g.lda;
    unsigned voffA[2], voffB[2];
#pragma unroll
    for (int i = 0; i < 2; ++i) { int R, C; stage_rc(tid * 16 + i * 8192, R, C); const int Rb = Epi::PERM ? ((R & ~31) + perm32(R & 31)) : R;
        voffA[i] = (unsigned)(R * lda + C) * 2u; voffB[i] = (unsigned)(Rb * K + C) * 2u; }
    const size_t kstep = (size_t)(BK * 2);
    const size_t hstepA = (size_t)HALF * lda * 2, hstepB = (size_t)HALF * K * 2;
    const size_t tstepA = 2 * hstepA, tstepB = 2 * hstepB;
    const unsigned ldsw = (unsigned)wid * 1024u;
    const int aoff = lds_byte(wr * 64 + fr, fq * 8), boff = lds_byte(wc * 32 + fr, fq * 8);
#define PG8_SA(b, h) (((b) * 2 + (h)) * HTB)
#define PG8_SB(b, h) ((4 + (b) * 2 + (h)) * HTB)
#ifdef EXP_DMA2
#define PG8_NREP 2
#else
#define PG8_NREP 1
#endif
#define PG8_STAGE(bufoff, gbase, voff) do { _Pragma("unroll") for (int _i = 0; _i < 2; ++_i) _Pragma("unroll") for (int _r = 0; _r < PG8_NREP; ++_r) \
        __builtin_amdgcn_global_load_lds((const unsigned*)((const char*)(gbase) + (voff)[_i]), (PG8_LAS unsigned*)(lds + (bufoff) + ldsw + _i * 8192), 16, 0, 0); } while (0)
#ifdef EXP_LDS2
#define PG8_DUP(addr) do { bf16x8 _d; asm volatile("ds_read_b128 %0, %1" : "=v"(_d) : "v"((unsigned)(addr)) : "memory"); } while (0)
#else
#define PG8_DUP(addr) do { } while (0)
#endif
#define PG8_LDA(dst, b, h) do { _Pragma("unroll") for (int m = 0; m < 4; ++m) _Pragma("unroll") for (int k = 0; k < 2; ++k) { dst[m][k] = *(const PG8_LAS bf16x8*)(lds + PG8_SA(b, h) + aoff + m * 2048 + k * 1024); PG8_DUP((unsigned)(uintptr_t)(lds + PG8_SA(b, h) + aoff + m * 2048 + k * 1024)); } } while (0)
#define PG8_LDB(dst, b, h) do { _Pragma("unroll") for (int n = 0; n < 2; ++n) _Pragma("unroll") for (int k = 0; k < 2; ++k) { dst[n][k] = *(const PG8_LAS bf16x8*)(lds + PG8_SB(b, h) + boff + n * 2048 + k * 1024); PG8_DUP((unsigned)(uintptr_t)(lds + PG8_SB(b, h) + boff + n * 2048 + k * 1024)); } } while (0)
#define PG8_MMA(ai, bj, At, Bt) do { __builtin_amdgcn_s_setprio(1); _Pragma("unroll") for (int m = 0; m < 4; ++m) _Pragma("unroll") for (int n = 0; n < 2; ++n) _Pragma("unroll") for (int k = 0; k < 2; ++k) \
        acc[ai][bj][m][n] = __builtin_amdgcn_mfma_f32_16x16x32_bf16(Bt[n][k], At[m][k], acc[ai][bj][m][n], 0, 0, 0); __builtin_amdgcn_s_setprio(0); } while (0)
#ifdef EXP_DMA2
#define PG8_WAIT_V(n) do { if ((n) == 0) asm volatile("s_waitcnt vmcnt(0)" ::: "memory"); else if ((n) == 2) asm volatile("s_waitcnt vmcnt(4)" ::: "memory"); else if ((n) == 4) asm volatile("s_waitcnt vmcnt(8)" ::: "memory"); \
    else if ((n) == 6) asm volatile("s_waitcnt vmcnt(12)" ::: "memory"); else asm volatile("s_waitcnt vmcnt(16)" ::: "memory"); } while (0)
#else
#define PG8_WAIT_V(n) asm volatile("s_waitcnt vmcnt(" #n ")" ::: "memory")
#endif
#define PG8_WAIT_L(n) asm volatile("s_waitcnt lgkmcnt(" #n ")" ::: "memory")
#define PG8_BAR __builtin_amdgcn_s_barrier()
#define PG8_SCHED __builtin_amdgcn_sched_barrier(0)
    Unit cur, nxt; int ui = 0;
    if (!S.next(0, cur)) return;
    f32x4 acc[2][2][4][2];
#pragma unroll
    for (int a = 0; a < 2; ++a)
#pragma unroll
        for (int b = 0; b < 2; ++b)
#pragma unroll
            for (int m = 0; m < 4; ++m)
#pragma unroll
                for (int n = 0; n < 2; ++n) acc[a][b][m][n] = (f32x4){0.f, 0.f, 0.f, 0.f};
    bf16x8 At[4][2], B0[2][2], B1[2][2];
    const char* cA = (const char*)g.A + (size_t)cur.pm * tstepA; const char* cB = (const char*)g.Bt + (size_t)cur.pn * tstepB;
    S.a_ready(cur);
    if constexpr (SP2) {
        PG8_STAGE(PG8_SB(0, 0), cB, voffB); PG8_STAGE(PG8_SB(0, 1), cB + hstepB, voffB); PG8_STAGE(PG8_SA(0, 0), cA, voffA); PG8_STAGE(PG8_SA(0, 1), cA + hstepA, voffA);
        if (wr == 1) PG8_BAR;
        PG8_WAIT_V(2); PG8_BAR;
        PG8_STAGE(PG8_SB(1, 0), cB + kstep, voffB); PG8_STAGE(PG8_SA(1, 0), cA + kstep, voffA); PG8_STAGE(PG8_SB(1, 1), cB + hstepB + kstep, voffB);
        PG8_WAIT_V(6); PG8_BAR;
    } else {
        PG8_STAGE(PG8_SB(0, 0), cB, voffB); PG8_STAGE(PG8_SA(0, 0), cA, voffA); PG8_STAGE(PG8_SB(0, 1), cB + hstepB, voffB); PG8_STAGE(PG8_SA(0, 1), cA + hstepA, voffA);
        if (wr == 1) PG8_BAR;
        PG8_WAIT_V(4); PG8_BAR;
        PG8_STAGE(PG8_SB(1, 0), cB + kstep, voffB); PG8_STAGE(PG8_SA(1, 0), cA + kstep, voffA); PG8_STAGE(PG8_SB(1, 1), cB + hstepB + kstep, voffB);
        PG8_WAIT_V(6); PG8_BAR;
    }
    for (;;) {
        const bool has_next = S.next(ui + 1, nxt);
        const char* nA = has_next ? (const char*)g.A + (size_t)nxt.pm * tstepA : cA; const char* nB = has_next ? (const char*)g.Bt + (size_t)nxt.pn * tstepB : cB;
        for (int t = 0; t < nt; t += 2) {
            const bool last = (t == nt - 2);
            const char* a1 = cA + (size_t)(t + 1) * kstep;
            const char* a2 = last ? nA : cA + (size_t)(t + 2) * kstep; const char* b2 = last ? nB : cB + (size_t)(t + 2) * kstep;
            const char* a3 = a2 + kstep; const char* b3 = b2 + kstep;
            if (last && has_next) S.a_ready(nxt);
            if constexpr (SP2) {
#ifdef TEST_DRAIN
            if (Epi::PERM && sizeof(Epi) && TEST_DRAIN) PG8_WAIT_V(0);
#endif
            PG8_LDB(B0, 0, 0); PG8_LDB(B1, 0, 1); PG8_SCHED; PG8_LDA(At, 0, 0); PG8_STAGE(PG8_SA(1, 1), a1 + hstepA, voffA);
            PG8_WAIT_V(8); PG8_WAIT_L(0); PG8_BAR; PG8_MMA(0, 0, At, B0); PG8_MMA(0, 1, At, B1); PG8_BAR; PG8_SCHED;
            PG8_LDA(At, 0, 1); PG8_STAGE(PG8_SB(0, 0), b2, voffB); PG8_STAGE(PG8_SB(0, 1), b2 + hstepB, voffB); PG8_STAGE(PG8_SA(0, 0), a2, voffA);
            PG8_WAIT_V(8); PG8_WAIT_L(0); PG8_BAR; PG8_MMA(1, 0, At, B0); PG8_MMA(1, 1, At, B1); PG8_BAR; PG8_SCHED;
            PG8_LDB(B0, 1, 0); PG8_LDB(B1, 1, 1); PG8_SCHED; PG8_LDA(At, 1, 0); PG8_STAGE(PG8_SA(0, 1), a2 + hstepA, voffA);
            PG8_WAIT_V(8); PG8_WAIT_L(0); PG8_BAR; PG8_MMA(0, 0, At, B0); PG8_MMA(0, 1, At, B1); PG8_BAR; PG8_SCHED;
            PG8_LDA(At, 1, 1); PG8_STAGE(PG8_SB(1, 0), b3, voffB); PG8_STAGE(PG8_SB(1, 1), b3 + hstepB, voffB); PG8_STAGE(PG8_SA(1, 0), a3, voffA);
            PG8_WAIT_V(8); PG8_WAIT_L(0); PG8_BAR; PG8_MMA(1, 0, At, B0); PG8_MMA(1, 1, At, B1); PG8_BAR; PG8_SCHED;
            } else {
            PG8_LDB(B0, 0, 0); PG8_SCHED; PG8_LDA(At, 0, 0); PG8_STAGE(PG8_SA(1, 1), a1 + hstepA, voffA);
            PG8_WAIT_L(8); PG8_BAR; PG8_WAIT_L(0); PG8_MMA(0, 0, At, B0); PG8_BAR; PG8_SCHED;
            PG8_LDB(B1, 0, 1); PG8_STAGE(PG8_SB(0, 0), b2, voffB);
            PG8_BAR; PG8_WAIT_L(0); PG8_MMA(0, 1, At, B1); PG8_BAR;
            PG8_LDA(At, 0, 1); PG8_STAGE(PG8_SA(0, 0), a2, voffA);
            PG8_BAR; PG8_WAIT_L(0); PG8_MMA(1, 0, At, B0); PG8_BAR; PG8_SCHED;
            PG8_STAGE(PG8_SB(0, 1), b2 + hstepB, voffB);
            PG8_WAIT_V(6); PG8_BAR; PG8_MMA(1, 1, At, B1); PG8_BAR;
            PG8_LDB(B0, 1, 0); PG8_SCHED; PG8_LDA(At, 1, 0); PG8_STAGE(PG8_SA(0, 1), a2 + hstepA, voffA);
            PG8_WAIT_L(8); PG8_BAR; PG8_WAIT_L(0); PG8_MMA(0, 0, At, B0); PG8_BAR; PG8_SCHED;
            PG8_LDB(B1, 1, 1); PG8_STAGE(PG8_SB(1, 0), b3, voffB);
            PG8_BAR; PG8_WAIT_L(0); PG8_MMA(0, 1, At, B1); PG8_BAR;
            PG8_LDA(At, 1, 1); PG8_STAGE(PG8_SA(1, 0), a3, voffA);
            PG8_BAR; PG8_WAIT_L(0); PG8_MMA(1, 0, At, B0); PG8_BAR; PG8_SCHED;
            PG8_STAGE(PG8_SB(1, 1), b3 + hstepB, voffB);
            PG8_WAIT_V(6); PG8_BAR; PG8_MMA(1, 1, At, B1); PG8_BAR;
            }
        }
        if constexpr (ALIGN_EPI) { if (wr == 0) PG8_BAR; }
        if constexpr (!Epi::AFTER_DRAIN) { E(acc, cur, wr, wc, fr, fq); S.done(cur); }
        if (!has_next) break;
#pragma unroll
        for (int a = 0; a < 2; ++a)
#pragma unroll
            for (int b = 0; b < 2; ++b)
#pragma unroll
                for (int m = 0; m < 4; ++m)
#pragma unroll
                    for (int n = 0; n < 2; ++n) acc[a][b][m][n] = (f32x4){0.f, 0.f, 0.f, 0.f};
        cur = nxt; cA = nA; cB = nB; ++ui;
        if constexpr (ALIGN_EPI) { if (wr == 1) PG8_BAR; }
    }
    PG8_WAIT_V(0);
    if constexpr (!ALIGN_EPI) { if (wr == 0) PG8_BAR; }
    PG8_BAR;
    if constexpr (Epi::AFTER_DRAIN) { E.fused(acc, cur, wr, wc, fr, fq, lds, wid, lane); S.done(cur); }
#undef PG8_SA
#undef PG8_SB
#undef PG8_STAGE
#undef PG8_LDA
#undef PG8_LDB
#undef PG8_MMA
#undef PG8_WAIT_V
#undef PG8_WAIT_L
#undef PG8_BAR
#undef PG8_SCHED
}
}
namespace att {
constexpr int B = 1, H = 8, HKV = 8, SQ = 16384, SKV = 16384, D = 128, QOFF = 0, WINDOW = SKV;
constexpr int OP = 1024;
constexpr int ZP = 10240;
constexpr float THR = 8.f;
constexpr bool WSKIP = false;
constexpr float SCALE = 0.08838834764831845f;
constexpr int NW = 8, QBLK = 32, KVBLK = 64, QB = NW * QBLK;
constexpr int SHM_V = KVBLK * D * 2, SHM_K = KVBLK * D * 2;
constexpr int LDS_BYTES = 2 * SHM_V + 2 * SHM_K + NW * 64 * 4;

using bf16 = __hip_bfloat16;
typedef short bf16x8 __attribute__((ext_vector_type(8)));
typedef short s16x4 __attribute__((ext_vector_type(4)));
typedef float f32x16 __attribute__((ext_vector_type(16)));
typedef float f32x4 __attribute__((ext_vector_type(4)));
typedef unsigned u32x4 __attribute__((ext_vector_type(4)));
template <class A, class Bt> struct same_t { static constexpr bool v = false; };
template <class A> struct same_t<A, A> { static constexpr bool v = true; };

#define KSWZ(row, colB) ((row) * 256 + ((colB) ^ (((row) & 7) << 4)))
#define SBAR() __builtin_amdgcn_sched_barrier(0)
__device__ __forceinline__ int v_st(int k, int c) { const int kk = (k & ~0xC) | ((k & 4) << 1) | ((k & 8) >> 1); return ((kk >> 3) * 4 + (c >> 5)) * 512 + ((kk & 7) * 32 + (c & 31)) * 2; }
__device__ __forceinline__ int v_rd_base(int lane) { return ((lane & 3) << 3) | (((lane >> 2) & 3) << 6) | (((lane >> 4) & 1) << 5) | (((lane >> 5) & 1) << 8); }
constexpr int v_rd_off(int d0, int ks, int half) { return d0 * 512 + ks * 4096 + half * 2048; }
__device__ __forceinline__ int crow(int r, int hi) { return (r & 3) + 8 * (r >> 2) + 4 * hi; }
__device__ __forceinline__ unsigned cvtpk(float lo, float hi) {
    unsigned r; asm volatile("v_cvt_pk_bf16_f32 %0, %1, %2" : "=v"(r) : "v"(lo), "v"(hi)); return r;
}
__device__ __forceinline__ bf16x8 pack8(f32x4 a, f32x4 b) {
    u32x4 w = {cvtpk(a[0], a[1]), cvtpk(a[2], a[3]), cvtpk(b[0], b[1]), cvtpk(b[2], b[3])};
    return *reinterpret_cast<bf16x8*>(&w);
}
template <class T> __device__ __forceinline__ bf16x8 load8(const T* p) {
    if constexpr (same_t<T, float>::v) { return pack8(*(const f32x4*)p, *(const f32x4*)(p + 4)); }
    else { return *reinterpret_cast<const bf16x8*>(p); }
}
__device__ __forceinline__ void mask_tile(f32x16& p0, f32x16& p1, int dq, unsigned W) {
    const float NEG = -__builtin_inff();
#pragma unroll
    for (int r = 0; r < 16; ++r) {
        const int c = (r & 3) + 8 * (r >> 2);
        if ((unsigned)(dq - c) >= W) p0[r] = NEG;
        if ((unsigned)(dq - c - 32) >= W) p1[r] = NEG;
    }
}
__device__ __forceinline__ void bias_tile(f32x16& p0, f32x16& p1, const float* cst, int hi) {
#pragma unroll
    for (int i = 0; i < 4; ++i) { const f32x4 a = *(const f32x4*)(cst + 8 * i + 4 * hi);
#pragma unroll
        for (int j = 0; j < 4; ++j) p0[4 * i + j] -= a[j]; }
    SBAR();
#pragma unroll
    for (int i = 0; i < 4; ++i) { const f32x4 b = *(const f32x4*)(cst + 32 + 8 * i + 4 * hi);
#pragma unroll
        for (int j = 0; j < 4; ++j) p1[4 * i + j] -= b[j]; }
}
__device__ __forceinline__ void partialSM(f32x16& p0, f32x16& p1, float& m_reg, float& mn, float& alpha) {
    float pmax = p0[0]; for (int r = 1; r < 16; ++r) pmax = fmaxf(pmax, p0[r]); for (int r = 0; r < 16; ++r) pmax = fmaxf(pmax, p1[r]);
    { auto rr = __builtin_amdgcn_permlane32_swap(__float_as_uint(pmax), __float_as_uint(pmax), false, false);
      pmax = fmaxf(__uint_as_float(rr[0]), __uint_as_float(rr[1])); }
    constexpr float C2 = 1.4426950408889634f * SCALE;
    if (__builtin_expect(__all((pmax - m_reg) * SCALE <= THR), 1)) { mn = m_reg; alpha = 1.f; }
    else { mn = fmaxf(m_reg, pmax); alpha = __builtin_amdgcn_exp2f((m_reg - mn) * C2); m_reg = mn; }
    const float mnL = -mn * C2;
    for (int r = 0; r < 16; ++r) p0[r] = fmaf(p0[r], C2, mnL); for (int r = 0; r < 16; ++r) p1[r] = fmaf(p1[r], C2, mnL);
    for (int r = 0; r < 16; ++r) p0[r] = __builtin_amdgcn_exp2f(p0[r]);
}
__device__ __forceinline__ void finishSM(f32x16& p0, f32x16& p1, float alpha, float& l_reg, bf16x8& pa0, bf16x8& pa1, bf16x8& pa2, bf16x8& pa3) {
    for (int r = 0; r < 16; ++r) p1[r] = __builtin_amdgcn_exp2f(p1[r]);
    float ps = 0; for (int r = 0; r < 16; ++r) ps += p0[r]; for (int r = 0; r < 16; ++r) ps += p1[r];
    { auto rr = __builtin_amdgcn_permlane32_swap(__float_as_uint(ps), __float_as_uint(ps), false, false);
      ps = __uint_as_float(rr[0]) + __uint_as_float(rr[1]); }
    l_reg = l_reg * alpha + ps;
#define PK4(P, B_, OUT) do { unsigned a0 = cvtpk(P[B_+0], P[B_+1]), a1 = cvtpk(P[B_+2], P[B_+3]);                          \
        unsigned b0 = cvtpk(P[B_+4], P[B_+5]), b1 = cvtpk(P[B_+6], P[B_+7]);                                             \
        auto r0 = __builtin_amdgcn_permlane32_swap(a0, b0, false, false); auto r1 = __builtin_amdgcn_permlane32_swap(a1, b1, false, false); \
        u32x4 w = {r0[0], r1[0], r0[1], r1[1]}; OUT = *reinterpret_cast<bf16x8*>(&w); } while (0)
    PK4(p0, 0, pa0); PK4(p0, 8, pa1); PK4(p1, 0, pa2); PK4(p1, 8, pa3);
#undef PK4
}
template <int KB, bool SK>
__device__ __forceinline__ void qkt(f32x16& p0, f32x16& p1, const char* K_lds, int r32, int hi, const bf16x8* qr, bool act) {
    if (SK && !act) { const float NEG = -__builtin_inff();
#pragma unroll
        for (int r = 0; r < 16; ++r) { p0[r] = NEG; p1[r] = NEG; } return; }
    p0 = f32x16{}; p1 = f32x16{};
    const char* kb[4];
#pragma unroll
    for (int dd = 0; dd < 4; ++dd) kb[dd] = K_lds + KB * SHM_K + KSWZ(r32, (dd * 16 + hi * 8) * 2);
#pragma unroll
    for (int d0 = 0; d0 < 8; ++d0) { const char* a = kb[d0 & 3] + (d0 >> 2) * 128;
        bf16x8 b0 = *reinterpret_cast<const bf16x8*>(a);
        bf16x8 b1 = *reinterpret_cast<const bf16x8*>(a + 32 * 256);
        p0 = __builtin_amdgcn_mfma_f32_32x32x16_bf16(b0, qr[d0], p0, 0, 0, 0);
        p1 = __builtin_amdgcn_mfma_f32_32x32x16_bf16(b1, qr[d0], p1, 0, 0, 0); }
}
template <int VB, bool SK>
__device__ __forceinline__ void pv_tile(f32x16* o, int vb0, bf16x8 pa0, bf16x8 pa1, bf16x8 pa2, bf16x8 pa3, bool act) {
    if (SK && !act) return;
#define TRRD(dst, off) asm volatile("ds_read_b64_tr_b16 %0, %1 offset:%2" : "=&v"(dst) : "v"(vb0), "i"(off) : "memory")
#define PV_D0(d0) do { s16x4 l0, l1, l2, l3, h0, h1, h2, h3; constexpr int b_ = VB * SHM_V + v_rd_off(d0, 0, 0);     \
        TRRD(l0, b_); TRRD(h0, b_ + 2048); TRRD(l1, b_ + 4096); TRRD(h1, b_ + 6144); TRRD(l2, b_ + 8192); TRRD(h2, b_ + 10240); TRRD(l3, b_ + 12288); TRRD(h3, b_ + 14336); \
        asm volatile("s_waitcnt lgkmcnt(0)" ::: "memory"); SBAR();                 \
        o[d0] = __builtin_amdgcn_mfma_f32_32x32x16_bf16(pa0, (bf16x8){l0[0], l0[1], l0[2], l0[3], h0[0], h0[1], h0[2], h0[3]}, o[d0], 0, 0, 0);   \
        o[d0] = __builtin_amdgcn_mfma_f32_32x32x16_bf16(pa1, (bf16x8){l1[0], l1[1], l1[2], l1[3], h1[0], h1[1], h1[2], h1[3]}, o[d0], 0, 0, 0);   \
        o[d0] = __builtin_amdgcn_mfma_f32_32x32x16_bf16(pa2, (bf16x8){l2[0], l2[1], l2[2], l2[3], h2[0], h2[1], h2[2], h2[3]}, o[d0], 0, 0, 0);   \
        o[d0] = __builtin_amdgcn_mfma_f32_32x32x16_bf16(pa3, (bf16x8){l3[0], l3[1], l3[2], l3[3], h3[0], h3[1], h3[2], h3[3]}, o[d0], 0, 0, 0); } while (0)
    PV_D0(0); PV_D0(1); PV_D0(2); PV_D0(3);
#undef PV_D0
#undef TRRD
}

template <class TIn, class TOut> struct BlockRef { const TIn* Q; const TIn* K; TOut* O; int P0; const float* C; int JLO; };
template <class TIn> struct Seam {
    bf16x8 qr[8];
    bf16x8 st_v0, st_v1, st_k0, st_k1; f32x4 sf0, sf1, sf2, sf3;
    f32x4 tq[16];
};
__device__ __forceinline__ int swa_jlo(int P0, int W) { const int lowk = P0 - W + 1; return lowk > 0 ? lowk / KVBLK : 0; }
#define ROW(p, k0, rr) ((p) + (size_t)((k0) + (rr)) * ZP + sc)
#define VMW() asm volatile("s_waitcnt vmcnt(0)" ::: "memory")
#define VMWN(n) asm volatile("s_waitcnt vmcnt(%0)" :: "i"(n) : "memory")
#define SLOAD_H(Kp, Vp, k0) do { S.st_v0 = load8<TIn>(ROW(Vp, k0, sr)); S.st_v1 = load8<TIn>(ROW(Vp, k0, 32 + sr));              \
                         S.st_k0 = load8<TIn>(ROW(Kp, k0, sr)); S.st_k1 = load8<TIn>(ROW(Kp, k0, 32 + sr)); } while (0)
#define SWRITE_HK(bf) do { *(bf16x8*)(K_lds + (bf) * SHM_K + kws) = S.st_k0; *(bf16x8*)(K_lds + (bf) * SHM_K + kws + 32 * 256) = S.st_k1; } while (0)
#define SWRITE_HV(bf) do { *(bf16x8*)(V_lds + (bf) * SHM_V + vst0) = S.st_v0; *(bf16x8*)(V_lds + (bf) * SHM_V + vst1) = S.st_v1; } while (0)
#define SWRITE_H(bf) do { SWRITE_HV(bf); SWRITE_HK(bf); } while (0)
#define SLOAD_F(p, k0) do { S.sf0 = *(const f32x4*)ROW(p, k0, sr); S.sf1 = *(const f32x4*)(ROW(p, k0, sr) + 4);                \
                            S.sf2 = *(const f32x4*)ROW(p, k0, 32 + sr); S.sf3 = *(const f32x4*)(ROW(p, k0, 32 + sr) + 4); } while (0)
#define SWRITE_KF(bf) do { *(bf16x8*)(K_lds + (bf) * SHM_K + kws) = pack8(S.sf0, S.sf1); *(bf16x8*)(K_lds + (bf) * SHM_K + kws + 32 * 256) = pack8(S.sf2, S.sf3); } while (0)
#define SWRITE_VF(bf) do { *(bf16x8*)(V_lds + (bf) * SHM_V + vst0) = pack8(S.sf0, S.sf1); *(bf16x8*)(V_lds + (bf) * SHM_V + vst1) = pack8(S.sf2, S.sf3); } while (0)
template <class TIn, class TOut>
__device__ __forceinline__ void causal_swa_prime(const BlockRef<TIn, TOut>& cur, int W, char* lds, Seam<TIn>& S) {
    constexpr bool F32 = same_t<TIn, float>::v;
    int tid_ = threadIdx.x; asm volatile("" : "+v"(tid_));
    const int tid = tid_, wid = __builtin_amdgcn_readfirstlane(tid >> 6), lane = tid & 63, r32 = lane & 31, hi = lane >> 5;
    const int sr = tid >> 4, sc = (tid & 15) * 8, kws = KSWZ(sr, sc * 2); char* K_lds = lds + 2 * SHM_V;
    const int kb0 = cur.JLO * KVBLK;
    for (int d0 = 0; d0 < 8; ++d0) S.qr[d0] = load8<TIn>(cur.Q + (size_t)(wid * QBLK + r32) * ZP + d0 * 16 + hi * 8);
    if constexpr (F32) { SLOAD_F((const float*)cur.K, kb0); VMW(); SWRITE_KF(0); SBAR(); SLOAD_F((const float*)(cur.K + 1024), kb0); }
    else { SLOAD_H(cur.K, (cur.K + 1024), kb0); VMW(); SWRITE_HK(0); }
    __syncthreads();
}
template <class TIn, class TOut>
__device__ __forceinline__ void causal_swa_block(const BlockRef<TIn, TOut>& cur, const BlockRef<TIn, TOut>& nxt, int skv, int W, char* lds, Seam<TIn>& S, const float* csl) {
    constexpr bool F32 = same_t<TIn, float>::v;
    int tid_ = threadIdx.x; asm volatile("" : "+v"(tid_));
    const int tid = tid_, wid = __builtin_amdgcn_readfirstlane(tid >> 6), lane = tid & 63, r32 = lane & 31, hi = lane >> 5;
    const int j_lo = cur.JLO;
    int j_hi = (cur.P0 + QB - 1) / KVBLK + 1; if (j_hi > skv / KVBLK) j_hi = skv / KVBLK;
    const int NT = j_hi - j_lo;
    const int kbn = nxt.JLO * KVBLK;
    const int qlo = cur.P0 + wid * QBLK, qm = qlo + r32 - 4 * hi;
    char* V_lds = lds; char* K_lds = lds + 2 * SHM_V;
    float* ws = (float*)(lds + 2 * SHM_V + 2 * SHM_K) + wid * 64; float* li_l = ws, * al_l = ws + 32;
    float m_reg = -1e30f, l_reg = 0; f32x16 o[4] = {};
    const int sr = tid >> 4, sc = (tid & 15) * 8, vst0 = v_st(sr, sc), vst1 = v_st(32 + sr, sc), kws = KSWZ(sr, sc * 2);
    const int vb0 = (int)(uintptr_t)V_lds + v_rd_base(lane);
    const TIn* Kh = cur.K; const TIn* Vh = (cur.K + 1024);
#define RESC(a) do { if (__any((a) < 1.f)) { if (hi == 0) al_l[r32] = (a); asm volatile("s_waitcnt lgkmcnt(0)" ::: "memory");              \
                     for (int d_ = 0; d_ < 4; ++d_) for (int r = 0; r < 16; ++r) o[d_][r] *= al_l[crow(r, hi)]; } } while (0)
#define KBASE(t) ((j_lo + (t)) * KVBLK)
#define ACT(t) (KBASE(t) <= qlo + QBLK - 1 && KBASE(t) + KVBLK - 1 >= qlo - W + 1)
#define MASKT(P0_, P1_, t) do { const int kb_ = KBASE(t); bias_tile(P0_, P1_, csl + kb_, hi); if ((!SK || ACT(t)) && (kb_ + KVBLK - 1 > qlo || kb_ <= qlo + QBLK - 1 - W)) mask_tile(P0_, P1_, qm - kb_, (unsigned)W); } while (0)
    constexpr int NQL = F32 ? 16 : 8;
    constexpr bool SK = WSKIP && !F32;
#define SEAM_K0() do { VMWN(NQL); if constexpr (F32) { SWRITE_KF(0); SBAR(); SLOAD_F((const float*)(nxt.K + 1024), kbn); } else { SWRITE_HK(0); } SBAR(); } while (0)
    f32x16 pA0, pA1, pB0, pB1; float mnA, mnB, alA, alB; bf16x8 pa0, pa1, pa2, pa3;
    if constexpr (F32) { VMW(); SWRITE_VF(0); SBAR(); } else { SWRITE_HV(0); SBAR(); }
    if (NT > 1) { if constexpr (F32) SLOAD_F((const float*)Kh, KBASE(1)); else SLOAD_H(Kh, Vh, KBASE(1)); }
    SBAR(); qkt<0, SK>(pA0, pA1, K_lds, r32, hi, S.qr, ACT(0));
    if constexpr (F32) { if (NT > 1) { VMW(); SWRITE_KF(1); SBAR(); SLOAD_F((const float*)Vh, KBASE(1)); } }
    MASKT(pA0, pA1, 0); partialSM(pA0, pA1, m_reg, mnA, alA);
    if (NT > 1) { VMW(); if constexpr (F32) { SWRITE_VF(1); SBAR(); if (NT > 2) SLOAD_F((const float*)Kh, KBASE(2)); } else SWRITE_H(1); }
    __syncthreads();
#define HALF_STEP(PX0, PX1, mnX, alX, PY0, PY1, alY, t, KB, VB, SB) do {                                                      \
        if constexpr (!F32) { if ((t) + 1 < NT) SLOAD_H(Kh, Vh, KBASE((t) + 1)); }     \
        SBAR(); qkt<KB, SK>(PX0, PX1, K_lds, r32, hi, S.qr, ACT(t));                                             \
        finishSM(PY0, PY1, alY, l_reg, pa0, pa1, pa2, pa3); SBAR();                                                           \
        if ((t) + 1 < NT) { if constexpr (F32) { VMW(); SWRITE_KF(SB); SBAR(); SLOAD_F((const float*)Vh, KBASE((t) + 1)); }  \
                            SBAR(); }                                               \
        pv_tile<VB, SK>(o, vb0, pa0, pa1, pa2, pa3, ACT((t) - 1)); MASKT(PX0, PX1, (t)); partialSM(PX0, PX1, m_reg, mnX, alX);                                        \
        __syncthreads();                                                                                                      \
        if ((t) + 1 < NT) { VMW(); if constexpr (F32) { SWRITE_VF(SB); SBAR(); if ((t) + 2 < NT) SLOAD_F((const float*)Kh, KBASE((t) + 2)); } \
                            else { SWRITE_H(SB); } }                                                                          \
        RESC(alX); __syncthreads(); } while (0)
    for (int t = 1; t + 1 < NT; t += 2) {
        HALF_STEP(pB0, pB1, mnB, alB, pA0, pA1, alA, t, 1, 0, 0);
        HALF_STEP(pA0, pA1, mnA, alA, pB0, pB1, alB, t + 1, 0, 1, 1);
    }
    const bool even = (NT & 1) == 0;
    if (even) { SBAR(); qkt<1, SK>(pB0, pB1, K_lds, r32, hi, S.qr, ACT(NT - 1)); SBAR(); }
#define QROW(e) (nxt.Q + (size_t)(wid * QBLK + r32) * ZP + ((e) >> 1) * 16 + hi * 8 + ((e) & 1) * 4)
    if constexpr (F32) { SLOAD_F((const float*)nxt.K, kbn); SBAR();
#pragma unroll
        for (int e = 0; e < 8; ++e) S.tq[e] = *(const f32x4*)QROW(e); }
    else { SLOAD_H(nxt.K, (nxt.K + 1024), kbn); SBAR();
#pragma unroll
        for (int d0 = 0; d0 < 8; ++d0) S.qr[d0] = load8<TIn>(nxt.Q + (size_t)(wid * QBLK + r32) * ZP + d0 * 16 + hi * 8); }
    SBAR();
    finishSM(pA0, pA1, alA, l_reg, pa0, pa1, pa2, pa3); SBAR();
    if constexpr (F32) {
#pragma unroll
        for (int e = 8; e < 16; ++e) S.tq[e] = *(const f32x4*)QROW(e); SBAR(); }
#undef QROW
    pv_tile<0, SK>(o, vb0, pa0, pa1, pa2, pa3, ACT(even ? NT - 2 : NT - 1));
    if (even) { MASKT(pB0, pB1, NT - 1); partialSM(pB0, pB1, m_reg, mnB, alB); __syncthreads(); RESC(alB);
        finishSM(pB0, pB1, alB, l_reg, pa0, pa1, pa2, pa3); SBAR(); pv_tile<1, SK>(o, vb0, pa0, pa1, pa2, pa3, ACT(NT - 1)); }
    SBAR(); SEAM_K0();
    if (hi == 0) li_l[r32] = l_reg; asm volatile("s_waitcnt lgkmcnt(0)" ::: "memory");
    float rli[16];
#pragma unroll
    for (int r = 0; r < 16; ++r) rli[r] = __builtin_amdgcn_rcpf(li_l[crow(r, hi)]);
    TOut* Ow = cur.O + (size_t)(wid * QBLK) * OP;
#pragma unroll
    for (int r = 0; r < 16; ++r) { const int orow = crow(r, hi);
#pragma unroll
        for (int d0 = 0; d0 < 4; ++d0) { const float v = o[d0][r] * rli[r];
            if constexpr (same_t<TOut, float>::v) { Ow[(size_t)orow * OP + d0 * 32 + r32] = v; }
            else { const float vn = __shfl_xor(v, 1);
                   if ((r32 & 1) == 0) *(unsigned*)(Ow + (size_t)orow * OP + d0 * 32 + r32) = cvtpk(v, vn); } } }
    if constexpr (F32) {
#pragma unroll
        for (int d0 = 0; d0 < 8; ++d0) S.qr[d0] = pack8(S.tq[2 * d0], S.tq[2 * d0 + 1]); }
    __syncthreads();
#undef RESC
#undef KBASE
#undef ACT
#undef MASKT
#undef SEAM_K0
#undef HALF_STEP
}
#undef ROW
#undef VMW
#undef VMWN
#undef SLOAD_H
#undef SWRITE_HK
#undef SWRITE_HV
#undef SWRITE_H
#undef SLOAD_F
#undef SWRITE_KF
#undef SWRITE_VF


}
namespace mk {
#define LAS __attribute__((address_space(3)))
typedef unsigned short bf16;
typedef unsigned v4u __attribute__((ext_vector_type(4)));
typedef unsigned v2u __attribute__((ext_vector_type(2)));
typedef float f32x4 __attribute__((ext_vector_type(4)));
constexpr int S = 16384, DM = 2048, NIN = 10240, NINSRC = 10248, CWD = 1024, FF = 8192, NH = 8, FCOL = 6144;
constexpr float EPS = 1e-6f, SQRT_HD = 11.313708498984761f;
constexpr size_t MiB = 1u << 20;
constexpr size_t WS_CTR = 32 * 1024  , WS_RSS = 128 * 1024, WS_BAR = 16 * 1024, CTL_ZERO_BYTES = 64 * 1024, WS_NRM = 64 * 1024, WS_LOGF = 1 * MiB, WS_CS = 1 * MiB + 512 * 1024, WS_WIN = 2 * MiB, WS_WC = 42 * MiB, WS_WA = 46 * MiB, WS_WMIX = 50 * MiB, WS_W1 = 58 * MiB, WS_W2 = 90 * MiB;
constexpr size_t WS_Z = 128 * MiB, WS_XN = 448 * MiB, WS_CONVY = 512 * MiB, WS_ATTO = 544 * MiB, WS_RN2 = 576 * MiB, WS_END = 577 * MiB;
constexpr int LDS_BYTES = att::LDS_BYTES + 65536 + 128;
static_assert(LDS_BYTES >= pg8::STAGE_BYTES, "LDS");
constexpr int NTHR = 512, NWAVES = 8;

#define LDS_WAIT() asm volatile("s_waitcnt lgkmcnt(0)" ::: "memory")
__device__ __forceinline__ unsigned f2bf(float f) { unsigned u = __builtin_bit_cast(unsigned, f); return (u + 0x7fffu + ((u >> 16) & 1u)) >> 16; }
__device__ __forceinline__ unsigned pk2(float lo, float hi) { return f2bf(lo) | (f2bf(hi) << 16); }
__device__ __forceinline__ float wave_sum(float v) {
#pragma unroll
    for (int o = 1; o < 64; o <<= 1) v += __shfl_xor(v, o);
    return v;
}
__device__ __forceinline__ void transpose_item(const float* W, int ldw, int split, int K, int N, bf16* WT, LAS float* scr, int item, int lane) {
    const int nblk = N / 32, kb = item / nblk, nb = item % nblk, k0 = 64 * kb, n0 = 32 * nb, c0 = n0 + (n0 >= split ? 8 : 0);
#pragma unroll 8
    for (int i = 0; i < 32; ++i) { const int kk = 2 * i + (lane >> 5); scr[kk * 33 + (lane & 31)] = W[(size_t)(k0 + kk) * ldw + c0 + (lane & 31)]; }
    LDS_WAIT(); asm volatile("" ::: "memory");
    const int c = lane & 7;
#pragma unroll
    for (int j = 0; j < 4; ++j) { const int n = (lane >> 3) + 8 * j; const LAS float* s = scr + (8 * c) * 33 + n;
        v4u o; o.x = pk2(s[0 * 33], s[1 * 33]); o.y = pk2(s[2 * 33], s[3 * 33]); o.z = pk2(s[4 * 33], s[5 * 33]); o.w = pk2(s[6 * 33], s[7 * 33]);
        *(v4u*)(WT + (size_t)(n0 + n) * K + k0 + 8 * c) = o; }
    LDS_WAIT(); asm volatile("" ::: "memory");
}
__device__ __forceinline__ void rms_load(f32x4 (&v)[8], const float* xrow, int lane) {
    const f32x4* xr = (const f32x4*)xrow + lane;
#pragma unroll
    for (int j = 0; j < 8; ++j) v[j] = xr[64 * j];
}
template <bool OUT_BF16, bool LOGF>
__device__ __forceinline__ void rms_row(const f32x4 (&v)[8], const float* g, bf16* orow, float* frow, int lane, const LAS float* gwf, float* logf_out, const float* bfp) {
    float s = 0.f;
#pragma unroll
    for (int j = 0; j < 8; ++j) { s += (v[j].x * v[j].x + v[j].y * v[j].y) + (v[j].z * v[j].z + v[j].w * v[j].w); }
    const float rstd = 1.0f / sqrtf(wave_sum(s) * (1.0f / DM) + EPS);
    if (LOGF) {
        float mine = 0.f;
#pragma nounroll
        for (int jj = 0; jj < 8; ++jj) { float t = 0.f;
#pragma unroll
            for (int j = 0; j < 8; ++j) { const f32x4 w = *(const LAS f32x4*)(gwf + jj * DM + 256 * j + 4 * lane); t += (v[j].x * w.x + v[j].y * w.y) + (v[j].z * w.z + v[j].w * w.w); }
            t = wave_sum(t) * rstd; mine = (lane == jj) ? t : mine; }
        if (lane < 8) { const float z = mine + bfp[lane]; logf_out[lane] = fminf(z, 0.f) - __logf(1.0f + __expf(-fabsf(z))); }
    }
#pragma unroll
    for (int j = 0; j < 8; ++j) { const f32x4 gg = ((const f32x4*)g)[64 * j + lane]; const f32x4 y = v[j] * rstd * gg;
        if (OUT_BF16) { v2u o; o.x = pk2(y.x, y.y); o.y = pk2(y.z, y.w); ((v2u*)orow)[64 * j + lane] = o; }
        else ((f32x4*)frow)[64 * j + lane] = y; }
}
__device__ __forceinline__ void cumsum_head(const float* logf, float* cs, int h, LAS float* sm, int tid) {
    const int lane = tid & 63, wave = tid >> 6;
    float v[32]; const float* p = logf + (size_t)(32 * tid) * NH + h; float s = 0.f;
#pragma unroll
    for (int i = 0; i < 32; ++i) { v[i] = p[i * NH]; }
#pragma unroll
    for (int i = 0; i < 32; ++i) { s += v[i]; }
    float inc = s;
#pragma unroll
    for (int o = 1; o < 64; o <<= 1) { const float n = __shfl_up(inc, o); if (lane >= o) inc += n; }
    if (lane == 63) sm[wave] = inc;
    __syncthreads();
    float wp = 0.f;
#pragma unroll
    for (int w = 0; w < 8; ++w) wp += (w < wave) ? sm[w] : 0.f;
    float run = wp + inc - s;
    float* o = cs + (size_t)h * S + 32 * tid;
#pragma unroll
    for (int i = 0; i < 32; i += 4) { f32x4 q; run += v[i]; q.x = run * SQRT_HD; run += v[i + 1]; q.y = run * SQRT_HD; run += v[i + 2]; q.z = run * SQRT_HD; run += v[i + 3]; q.w = run * SQRT_HD; *(f32x4*)(o + i) = q; }
    __syncthreads();
}
__device__ __forceinline__ void unpack8f(const v4u w, float (&f)[8]) {
    f[0] = __uint_as_float(w.x << 16); f[1] = __uint_as_float(w.x & 0xffff0000u); f[2] = __uint_as_float(w.y << 16); f[3] = __uint_as_float(w.y & 0xffff0000u);
    f[4] = __uint_as_float(w.z << 16); f[5] = __uint_as_float(w.z & 0xffff0000u); f[6] = __uint_as_float(w.w << 16); f[7] = __uint_as_float(w.w & 0xffff0000u);
}
__device__ __forceinline__ void conv_item(const bf16* z, const float* cw, bf16* convy, int item, int lane) {
    const int t0 = (item >> 1) * 16, c0 = (item & 1) * 512 + lane * 8;
    float w0[8], w1[8], w2[8], p2[8], p1[8];
#pragma unroll
    for (int e = 0; e < 8; ++e) { w0[e] = cw[c0 + e]; w1[e] = cw[CWD + c0 + e]; w2[e] = cw[2 * CWD + c0 + e]; p2[e] = 0.f; p1[e] = 0.f; }
    if (t0 >= 2) {
        float a[8], b[8];
        unpack8f(*(const v4u*)(z + (size_t)(t0 - 2) * NIN + CWD + c0), a); unpack8f(*(const v4u*)(z + (size_t)(t0 - 2) * NIN + 2 * CWD + c0), b);
#pragma unroll
        for (int e = 0; e < 8; ++e) p2[e] = a[e] * b[e];
        unpack8f(*(const v4u*)(z + (size_t)(t0 - 1) * NIN + CWD + c0), a); unpack8f(*(const v4u*)(z + (size_t)(t0 - 1) * NIN + 2 * CWD + c0), b);
#pragma unroll
        for (int e = 0; e < 8; ++e) p1[e] = a[e] * b[e];
    }
#pragma nounroll
    for (int rb = 0; rb < 16; rb += 8) {
        v4u xd[8], xa[8], xb[8];
#pragma unroll
        for (int q = 0; q < 8; ++q) { const bf16* zr = z + (size_t)(t0 + rb + q) * NIN + c0; xd[q] = *(const v4u*)(zr); xa[q] = *(const v4u*)(zr + CWD); xb[q] = *(const v4u*)(zr + 2 * CWD); }
#pragma unroll
        for (int q = 0; q < 8; ++q) { float a[8], b[8], d[8], y[8];
            unpack8f(xd[q], d); unpack8f(xa[q], a); unpack8f(xb[q], b);
#pragma unroll
            for (int e = 0; e < 8; ++e) { const float pc = a[e] * b[e]; y[e] = d[e] * (w0[e] * p2[e] + w1[e] * p1[e] + w2[e] * pc); p2[e] = p1[e]; p1[e] = pc; }
            v4u o; o.x = pk2(y[0], y[1]); o.y = pk2(y[2], y[3]); o.z = pk2(y[4], y[5]); o.w = pk2(y[6], y[7]);
            *(v4u*)(convy + (size_t)(t0 + rb + q) * CWD + c0) = o; }
    }
}

#define XB_TMO      128
#define XB_XCNT(j)  (256  + 64 * (j))
#define XB_XSUB(j)  (1280 + 64 * (j))
#define XB_XGEN(j)  (2304 + 64 * (j))
#define XB_TOP      3328
#define XB_TOPGEN   3392
#define XCD_BAR_WORDS 3456
#define XB_SPIN_CAP (1u << 18)

__device__ __forceinline__ unsigned xb_ld(unsigned* p)              { return __hip_atomic_load(p, __ATOMIC_RELAXED, __HIP_MEMORY_SCOPE_AGENT); }
__device__ __forceinline__ unsigned xb_add(unsigned* p, unsigned v) { return __hip_atomic_fetch_add(p, v, __ATOMIC_RELAXED, __HIP_MEMORY_SCOPE_AGENT); }
__device__ __forceinline__ unsigned xb_xcc_id() { return (unsigned)__builtin_amdgcn_s_getreg((3 << 11) | 20) & 0xFu; }
#define XB_SPIN(cond, bar) do { unsigned _sp = 0; while (cond) { __builtin_amdgcn_s_sleep(1); \
    if ((++_sp & 255u) == 0u) { if (xb_ld(&(bar)[XB_TMO])) break; if (_sp > XB_SPIN_CAP) { atomicAdd(&(bar)[XB_TMO], 1u); break; } } } } while (0)

struct XcdBarrier {
    unsigned* bar; unsigned x;
    volatile LAS unsigned* st;
};

__device__ __forceinline__ XcdBarrier xcd_barrier_post(unsigned* bar, volatile LAS unsigned* st) {
    XcdBarrier b; b.bar = bar; b.x = xb_xcc_id(); b.st = st;
    if (threadIdx.x == 0) (void)xb_add(&bar[XB_XCNT(b.x)], 1u);
    return b;
}
__device__ __forceinline__ void xcd_barrier_complete(unsigned* bar, unsigned x, unsigned& nloc, unsigned& nx) {
    const unsigned G = gridDim.x * gridDim.y * gridDim.z;
    unsigned sum, cnt, mine, sp = 0u;
    for (;;) {
        sum = 0u; cnt = 0u; mine = 0u;
#pragma unroll
        for (unsigned j = 0; j < 16; ++j) { const unsigned c = xb_ld(&bar[XB_XCNT(j)]); sum += c; cnt += (c > 0u) ? 1u : 0u; mine = (j == x) ? c : mine; }
        if (sum == G) break;
        __builtin_amdgcn_s_sleep(1);
        if ((++sp & 255u) == 0u) { if (xb_ld(&bar[XB_TMO])) break; if (sp > XB_SPIN_CAP) { atomicAdd(&bar[XB_TMO], 1u); break; } }
    }
    nloc = mine > 0u ? mine : 1u; nx = cnt > 0u ? cnt : 1u;
}

__device__ __forceinline__ void xcd_barrier(const XcdBarrier& b) {
    asm volatile("s_waitcnt vmcnt(0)" ::: "memory");
    __syncthreads();
    if (threadIdx.x == 0) {
        unsigned* bar = b.bar;
        __builtin_amdgcn_s_waitcnt(0);
        unsigned nloc = b.st[0], nx = b.st[1];
        if (nloc == 0u) { xcd_barrier_complete(bar, b.x, nloc, nx); b.st[0] = nloc; b.st[1] = nx; }
        const unsigned old = xb_add(&bar[XB_XSUB(b.x)], 1u);
        const unsigned gen = old / nloc;
        if (old + 1u == (gen + 1u) * nloc) {
            __builtin_amdgcn_fence(__ATOMIC_RELEASE, "agent");
            asm volatile("s_waitcnt vmcnt(0)" ::: "memory");
            const unsigned og = xb_add(&bar[XB_TOP], 1u);
            const unsigned tg = og / nx;
            if (og + 1u == (tg + 1u) * nx) xb_add(&bar[XB_TOPGEN], 1u);
            else XB_SPIN(xb_ld(&bar[XB_TOPGEN]) == tg, bar);
            __builtin_amdgcn_fence(__ATOMIC_ACQUIRE, "agent");
            xb_add(&bar[XB_XGEN(b.x)], 1u);
            asm volatile("s_waitcnt vmcnt(0)" ::: "memory");
        } else {
            XB_SPIN(xb_ld(&bar[XB_XGEN(b.x)]) == gen, bar);
            __builtin_amdgcn_fence(__ATOMIC_ACQUIRE, "agent");
            asm volatile("s_waitcnt vmcnt(0)" ::: "memory");
        }
    }
    __syncthreads();
}

__device__ __forceinline__ int compute_jlo(const float* csh, const float* rq, const float* rk, int qb_in, int* sm, int tid0) {
    int t = tid0; asm volatile("" : "+v"(t)); int qb = qb_in; asm volatile("" : "+s"(qb));
    if (t == 0) { sm[0] = 4 * qb; sm[1] = 0; sm[3] = 0; }
    float kn = 0.f, qn = (t < 256) ? rq[qb * 256 + t] : 0.f;
    const int nk = (qb + 1) * 256;
#pragma unroll
    for (int j = 0; j < 8; ++j) { if (j * 2048 < nk) { const f32x4 v = ((const f32x4*)rk)[j * NTHR + t]; kn = fmaxf(kn, fmaxf(fmaxf(v.x, v.y), fmaxf(v.z, v.w))); } }
#define JLO_SW(o) do { kn = fmaxf(kn, __int_as_float(__builtin_amdgcn_ds_swizzle(__float_as_int(kn), 0x1f | ((o) << 10)))); qn = fmaxf(qn, __int_as_float(__builtin_amdgcn_ds_swizzle(__float_as_int(qn), 0x1f | ((o) << 10)))); } while (0)
    JLO_SW(1); JLO_SW(2); JLO_SW(4); JLO_SW(8); JLO_SW(16);
#undef JLO_SW
    __syncthreads();
    if ((t & 31) == 0) { atomicMax((unsigned*)&sm[1], __float_as_uint(kn)); atomicMax((unsigned*)&sm[3], __float_as_uint(qn)); }
    __syncthreads();
    const float K2 = __uint_as_float((unsigned)sm[1]), Q2 = __uint_as_float((unsigned)sm[3]);
    const float qk2 = 2.0f * sqrtf(Q2 * K2) * 1.01f, c0 = csh[qb * 256];
    if (t < 4 * qb) { const float ce = csh[64 * t + 63]; if (!((qk2 + c0 - ce) <= -110.0f * SQRT_HD)) atomicMin(&sm[0], t); }
    __syncthreads();
    const int j = sm[0];
    __syncthreads();
    return j;
}

struct Args { const float* in[13]; float* out; unsigned char* ws; };

__global__ void __launch_bounds__(NTHR, 2) fwd_megakernel(Args args) {
    extern __shared__ __attribute__((aligned(16))) unsigned char lds[];
    cg::grid_group grid = cg::this_grid();
    LAS unsigned char* L = (LAS unsigned char*)lds;
    const int tid0 = threadIdx.x, wave = __builtin_amdgcn_readfirstlane(tid0 >> 6);
#define LAUNDER_TID() int tid = tid0; asm volatile("" : "+v"(tid)); const int lane = tid & 63
    const int G = gridDim.x, bid = blockIdx.x, gw = bid * NWAVES + wave, NGW = G * NWAVES;
    unsigned char* ws = args.ws;
    float* rn2 = (float*)(ws + WS_RN2);
    float* logf = (float*)(ws + WS_LOGF); float* cs = (float*)(ws + WS_CS);
    bf16* Win_t = (bf16*)(ws + WS_WIN); bf16* Wc_t = (bf16*)(ws + WS_WC); bf16* Wa_t = (bf16*)(ws + WS_WA); bf16* Wmix_t = (bf16*)(ws + WS_WMIX);
    bf16* W1_t = (bf16*)(ws + WS_W1); bf16* W2_t = (bf16*)(ws + WS_W2);
    bf16* Z = (bf16*)(ws + WS_Z); bf16* XN = (bf16*)(ws + WS_XN); bf16* CONVY = (bf16*)(ws + WS_CONVY); bf16* ATTO = (bf16*)(ws + WS_ATTO);
    bf16* XG = (bf16*)(ws + WS_Z + 256 * MiB);
    float* rowss = (float*)(ws + WS_RSS);
    float* xres = args.out;
    volatile LAS unsigned* bst = (volatile LAS unsigned*)(L + att::LDS_BYTES + 65536 + 64);
    if (tid0 < 2) bst[tid0] = 0u;
    __syncthreads();
    const XcdBarrier xbar = xcd_barrier_post((unsigned*)(ws + WS_BAR), bst);
#ifdef EXTRA_SYNCS
#define GRID_SYNC() do { xcd_barrier(xbar); } while (0)
#else
#define GRID_SYNC() do { xcd_barrier(xbar); } while (0)
#endif

#pragma nounroll
    for (int l = 0; l < 2; ++l) {
        const float* xin = (l == 0) ? args.in[0] : (const float*)xres;
        const float* g_mix = args.in[1] + (size_t)l * DM; const float* w_in = args.in[2] + (size_t)l * DM * NINSRC;
        const float* b_f = args.in[3] + l * NH; const float* b_gate = args.in[4] + (size_t)l * 2 * DM; const float* conv_w = args.in[5] + (size_t)l * 3 * CWD;
        const float* w_c = args.in[6] + (size_t)l * CWD * DM; const float* w_a = args.in[7] + (size_t)l * CWD * DM; const float* w_mix = args.in[8] + (size_t)l * DM * DM;
        const float* g_mlp = args.in[9] + (size_t)l * DM; const float* w1 = args.in[10] + (size_t)l * DM * FF; const float* w2 = args.in[11] + (size_t)l * FF * DM;

#ifndef REP_P0
#define REP_P0 1
#endif
#pragma nounroll
        for (int rep_ = 0; rep_ < REP_P0; ++rep_) {
            if (rep_) __syncthreads();
            LAUNDER_TID();
            for (int b = bid; b < (16 * S) / (2 * NTHR); b += G) { rn2[b * 2 * NTHR + tid] = 0.f; rn2[b * 2 * NTHR + NTHR + tid] = 0.f; }
            if (bid == 1 % G) { for (int i = tid; i < S; i += NTHR) rowss[i] = 0.f; }
            LAS float* scr = (LAS float*)(L + wave * 16384);
            constexpr int I_IN = (DM / 64) * (NIN / 32), I_C = (CWD / 64) * (DM / 32), I_MIX = (DM / 64) * (DM / 32), I_1 = (DM / 64) * (FF / 32), I_2 = (FF / 64) * (DM / 32);
            constexpr int NITEMS = I_IN + 2 * I_C + I_MIX + I_1 + I_2;
            for (int it = gw; it < NITEMS; it += NGW) {
                int r = it;
                if (r < I_IN) { transpose_item(w_in, NINSRC, FCOL, DM, NIN, Win_t, scr, r, lane); continue; } r -= I_IN;
                if (r < I_C) { transpose_item(w_c, DM, 1 << 30, CWD, DM, Wc_t, scr, r, lane); continue; } r -= I_C;
                if (r < I_C) { transpose_item(w_a, DM, 1 << 30, CWD, DM, Wa_t, scr, r, lane); continue; } r -= I_C;
                if (r < I_MIX) { transpose_item(w_mix, DM, 1 << 30, DM, DM, Wmix_t, scr, r, lane); continue; } r -= I_MIX;
                if (r < I_1) { transpose_item(w1, FF, 1 << 30, DM, FF, W1_t, scr, r, lane); continue; } r -= I_1;
                transpose_item(w2, DM, 1 << 30, FF, DM, W2_t, scr, r, lane);
            }
            __syncthreads();
            LAS float* gwf = (LAS float*)L;
#pragma unroll
            for (int i_ = 0; i_ < DM / NTHR; ++i_) { const int k = tid + i_ * NTHR; const float* wp = w_in + (size_t)k * NINSRC + FCOL; const f32x4 a = *(const f32x4*)wp, b = *(const f32x4*)(wp + 4); const float gk = g_mix[k];
                gwf[0 * DM + k] = gk * a.x; gwf[1 * DM + k] = gk * a.y; gwf[2 * DM + k] = gk * a.z; gwf[3 * DM + k] = gk * a.w;
                gwf[4 * DM + k] = gk * b.x; gwf[5 * DM + k] = gk * b.y; gwf[6 * DM + k] = gk * b.z; gwf[7 * DM + k] = gk * b.w; }
            __syncthreads();
            {   f32x4 rv[8], rn[8]; rms_load(rv, xin + (size_t)gw * DM, lane);
                for (int m = gw; m < S; m += NGW) {
                    const int mn = (m + NGW < S) ? m + NGW : m; rms_load(rn, xin + (size_t)mn * DM, lane);
                    rms_row<true, true>(rv, g_mix, XN + (size_t)m * DM, nullptr, lane, gwf, logf + (size_t)m * NH, b_f);
#pragma unroll
                    for (int j = 0; j < 8; ++j) rv[j] = rn[j]; } }
        }
        if (l == 0) { __syncthreads(); grid.sync(); } else GRID_SYNC();

        {
            { LAUNDER_TID(); if (bid < NH) cumsum_head(logf, cs, bid, (LAS float*)L, tid); }
            pg8::Gemm g{XN, Win_t, S, NIN, DM, DM}; pg8::StaticOrder So; So.init(S, NIN, G, bid);
            pg8::Epi<pg8::EP_INPROJ> E{Z, NIN, nullptr, 0, nullptr, (3 * CWD) / 256  , nullptr, nullptr, b_gate, FCOL / 256, rn2};
#ifndef REP_P1
#define REP_P1 1
#endif
#pragma nounroll
            for (int rep_ = 0; rep_ < REP_P1; ++rep_)
            pg8::gemm_phase<pg8::Epi<pg8::EP_INPROJ>, pg8::StaticOrder, true, true>(L, g, So, E);
        }
        GRID_SYNC();

#ifndef REP_P2
#define REP_P2 1
#endif
#pragma nounroll
        for (int rep_ = 0; rep_ < REP_P2; ++rep_) {
            if (rep_) GRID_SYNC();
            LAUNDER_TID();
            using abf = att::bf16; typedef att::BlockRef<abf, abf> BR;
            char* al = (char*)lds; float* csl = (float*)((char*)lds + att::LDS_BYTES);
            const abf* Qb = (const abf*)Z + 3 * CWD; const abf* Kb = (const abf*)Z + 4 * CWD;
            constexpr int NQB = S / att::QB, NITEM = NH * (NQB / 2);
            unsigned ord = 0u;
            {   float ce[NH];
#pragma unroll
                for (int h = 0; h < NH; ++h) ce[h] = cs[(size_t)h * S + S - 1];
#pragma unroll
                for (int hh = 0; hh < NH; ++hh) { int rr = 0;
#pragma unroll
                    for (int g2 = 0; g2 < NH; ++g2) rr += (ce[g2] > ce[hh] || (ce[g2] == ce[hh] && g2 < hh)) ? 1 : 0;
                    ord |= (unsigned)hh << (4 * rr); }
                ord = __builtin_amdgcn_readfirstlane(ord); }
            {
                unsigned* actr = (unsigned*)(ws + WS_CTR) + 64 * l + 16;
                int* smi2 = (int*)((char*)lds + att::LDS_BYTES + 65536);
                int Ls = (G % 8 == 0) ? (bid % 8) * (G / 8) + bid / 8 : bid; bool dyn = false;
#define MK_REF(r, Lx, ps) do { const int i_ = (Lx), rk_ = i_ >> 6, qb_ = (NQB - 1) - (i_ & (NQB - 1)), h_ = (int)((ord >> (4 * rk_)) & 7u); \
                    (r).Q = Qb + h_ * 128 + (size_t)qb_ * att::QB * NIN; (r).O = (abf*)ATTO + h_ * 128 + (size_t)qb_ * att::QB * CWD; (r).K = Kb + h_ * 128; (r).P0 = qb_ * att::QB; (r).C = cs + (size_t)h_ * S; (r).JLO = compute_jlo((r).C, rn2 + (size_t)h_ * S, rn2 + (size_t)(NH + h_) * S, qb_, (int*)((char*)lds + att::LDS_BYTES + 65536), tid0); } while (0)
                att::Seam<abf> Sm;
                for (;;) {
                    int pos;
                    if (!dyn) { pos = Ls; if (pos >= NITEM) { dyn = true; continue; } Ls += G; }
                    else { int t4 = tid0; asm volatile("" : "+v"(t4)); if (t4 == 0) smi2[2] = (int)atomicAdd(actr, 1u);
                        __syncthreads(); pos = NITEM + __builtin_amdgcn_readfirstlane(smi2[2]); __syncthreads();
                        if (pos >= 2 * NITEM) break; }
                    BR cur; MK_REF(cur, pos, 0);
                    att::causal_swa_prime<abf, abf>(cur, S, al, Sm);
                    { const int n4 = (cur.P0 + att::QB) / 4; int t2 = tid0; asm volatile("" : "+v"(t2)); for (int i = cur.JLO * 16 + t2; i < n4; i += NTHR) ((f32x4*)csl)[i] = ((const f32x4*)cur.C)[i]; }
                    __syncthreads();
                    att::causal_swa_block<abf, abf>(cur, cur, S, S, al, Sm, csl);
                }
#undef MK_REF
            }
            {   unsigned* ctr = (unsigned*)(ws + WS_CTR) + 64 * l; int* smi = (int*)((char*)lds + att::LDS_BYTES + 65536);
                int t3 = tid0; asm volatile("" : "+v"(t3)); const int lane3 = t3 & 63;
                for (;;) {
                    if (t3 == 0) smi[2] = (int)atomicAdd(ctr, 8u);
                    __syncthreads();
                    const int base = __builtin_amdgcn_readfirstlane(smi[2]);
                    __syncthreads();
                    if (base >= (S / 16) * 2) break;
                    conv_item(Z, conv_w, CONVY, base + wave, lane3);
                }
            }
        }
        GRID_SYNC();

        {
            pg8::Gemm g{CONVY, Wc_t, S, DM, CWD, CWD}; pg8::StaticOrder So; So.init(S, DM, G, bid);
            pg8::Epi<pg8::EP_T1> E{Z, NIN, Z + FCOL, NIN, nullptr, 0, nullptr, nullptr, nullptr, 0, nullptr};
            pg8::gemm_phase<pg8::Epi<pg8::EP_T1>, pg8::StaticOrder, true, true>(L, g, So, E);
        }
        {
            pg8::Gemm g{ATTO, Wa_t, S, DM, CWD, CWD}; pg8::StaticOrder So; So.init(S, DM, G, bid);
            pg8::Epi<pg8::EP_MERGE> E{XN, DM, Z + FCOL + DM, NIN, Z, NIN, nullptr, nullptr, nullptr, 0, nullptr};
            pg8::gemm_phase<pg8::Epi<pg8::EP_MERGE>, pg8::StaticOrder, true, true>(L, g, So, E);
        }
        GRID_SYNC();

        {
            pg8::Gemm g{XN, Wmix_t, S, DM, DM, DM}; pg8::StaticOrder So; So.init(S, DM, G, bid);
            pg8::Epi<pg8::EP_RESID_N> E{XG, DM, nullptr, 0, nullptr, 0, xin, xres, g_mlp, 0, rowss};
            pg8::gemm_phase<pg8::Epi<pg8::EP_RESID_N>, pg8::StaticOrder, true, true>(L, g, So, E);
        }
        GRID_SYNC();


        {
            pg8::Gemm g{XG, W1_t, S, FF, DM, DM}; pg8::StaticOrder So; So.init(S, FF, G, bid);
            pg8::Epi<pg8::EP_RELU2> E{Z, FF, nullptr, 0, nullptr, 0, nullptr, nullptr, nullptr, 0, rowss};
#ifndef REP_P7
#define REP_P7 1
#endif
#pragma nounroll
            for (int rep_ = 0; rep_ < REP_P7; ++rep_)
            pg8::gemm_phase<pg8::Epi<pg8::EP_RELU2>, pg8::StaticOrder, true, true>(L, g, So, E);
        }
        GRID_SYNC();

        {
            pg8::Gemm g{Z, W2_t, S, DM, FF, FF}; pg8::StaticOrder So; So.init(S, DM, G, bid);
            pg8::Epi<pg8::EP_RESID> E{nullptr, 0, nullptr, 0, nullptr, 0, xres, xres, nullptr, 0, nullptr};
            pg8::gemm_phase<pg8::Epi<pg8::EP_RESID>, pg8::StaticOrder, true, true>(L, g, So, E);
        }
        GRID_SYNC();
    }
#ifdef EXTRA_SYNCS
#pragma nounroll
    for (int i = 0; i < EXTRA_SYNCS; ++i) GRID_SYNC();
#endif
    {   LAUNDER_TID(); f32x4 rv[8], rn[8]; rms_load(rv, xres + (size_t)gw * DM, lane);
        for (int m = gw; m < S; m += NGW) {
            const int mn = (m + NGW < S) ? m + NGW : m; rms_load(rn, xres + (size_t)mn * DM, lane);
            rms_row<false, false>(rv, args.in[12], nullptr, xres + (size_t)m * DM, lane, nullptr, nullptr, nullptr);
#pragma unroll
            for (int j = 0; j < 8; ++j) rv[j] = rn[j]; } }
}
}

extern "C" void kernel_launch(void* const* d_in, const int* in_sizes, int n_in, void* d_out, int out_size, void* d_ws, size_t ws_size, hipStream_t stream) {
    static int grid = 0;
    if (grid == 0) {
        if (n_in != 13 || out_size != mk::S * mk::DM || ws_size < mk::WS_END) { fprintf(stderr, "kernel_launch: unexpected shapes (n_in %d out %d ws %zu)\n", n_in, out_size, ws_size); grid = -1; return; }
        int dev = 0, cus = 0, per_cu = 0;
        (void)hipGetDevice(&dev); (void)hipDeviceGetAttribute(&cus, hipDeviceAttributeMultiprocessorCount, dev);
        if (hipFuncSetAttribute((const void*)mk::fwd_megakernel, hipFuncAttributeMaxDynamicSharedMemorySize, mk::LDS_BYTES) != hipSuccess) { fprintf(stderr, "kernel_launch: hipFuncSetAttribute failed\n"); grid = -1; return; }
        if (hipOccupancyMaxActiveBlocksPerMultiprocessor(&per_cu, (const void*)mk::fwd_megakernel, mk::NTHR, mk::LDS_BYTES) != hipSuccess || per_cu < 1) { fprintf(stderr, "kernel_launch: occupancy query says %d\n", per_cu); per_cu = 1; }
        (void)hipGetLastError();
        grid = cus * per_cu;
    }
    if (grid < 0) return;
    if (hipMemsetAsync(d_ws, 0, mk::CTL_ZERO_BYTES, stream) != hipSuccess) { fprintf(stderr, "kernel_launch: hipMemsetAsync failed\n"); return; }
    mk::Args a{};
    for (int i = 0; i < 13; ++i) a.in[i] = (const float*)d_in[i];
    a.out = (float*)d_out; a.ws = (unsigned char*)d_ws;
    void* kargs[] = {&a};
    hipError_t e = hipLaunchCooperativeKernel((const void*)mk::fwd_megakernel, dim3(grid), dim3(mk::NTHR), kargs, mk::LDS_BYTES, stream);
    if (e != hipSuccess) fprintf(stderr, "kernel_launch: cooperative launch failed: %s (grid %d)\n", hipGetErrorString(e), grid);
}
```
